# Optimizing an MI355X kernel written in HIP

```python
import math
import jax
import jax.numpy as jnp
from jax import lax
import numpy as np


D_MODEL = 2048
BATCH = 8
SEQ = 2048
DEPTH = 2

HEAD_DIM = 64
N_HEADS_A = 12
DILATED_CONFIGS = ((128, 1), (512, 4), (2048, 16))
DILATED_BLOCK = 64
N_HEADS_B = 10
N_KV_B = 2
WINDOW_B = 128
BLOCK_B = 128
N_HEADS_C = 10
GRID_W = 64
NA_ROWS = 8
NA_COLS = 16
WIDTH_A = N_HEADS_A * HEAD_DIM
WIDTH_B = N_HEADS_B * HEAD_DIM
WIDTH_B_KV = N_KV_B * HEAD_DIM
WIDTH_C = N_HEADS_C * HEAD_DIM
MIX_WIDTH = WIDTH_A + WIDTH_B + WIDTH_C
IN_COLS = 3 * WIDTH_A + WIDTH_B + 2 * WIDTH_B_KV + 3 * WIDTH_C
D_FF = 5632
CONV_WIDTH = 3
ROPE_THETA = 10000.0
EPS = 1e-6
NEG_INF = -1e30

kernel_name = 'hybrid_parallel_local_attention_encoder'


def rms_normalize(x):
    x32 = x.astype(jnp.float32)
    return (x32 * lax.rsqrt(jnp.mean(x32 * x32, axis=-1, keepdims=True) + EPS)).astype(x.dtype)


def rmsnorm(x, gain):
    return rms_normalize(x) * gain


def heads(x, n):
    b, t, _ = x.shape
    return x.reshape(b, t, n, HEAD_DIM).transpose(0, 2, 1, 3)


def merge_heads(x):
    b, h, t, d = x.shape
    return x.transpose(0, 2, 1, 3).reshape(b, t, h * d)


def rotary(x):
    t, dh = x.shape[-2], x.shape[-1]
    inv_freq = ROPE_THETA ** (-jnp.arange(0, dh, 2, dtype=jnp.float32) / dh)
    ang = jnp.arange(t, dtype=jnp.float32)[:, None] * inv_freq[None, :]
    cos = jnp.cos(ang).astype(x.dtype)
    sin = jnp.sin(ang).astype(x.dtype)
    x1, x2 = x[..., : dh // 2], x[..., dh // 2:]
    return jnp.concatenate([x1 * cos - x2 * sin, x2 * cos + x1 * sin], axis=-1)


def banded_attention(q, k, v, half, block):
    n, g, length, dh = q.shape
    nb = length // block
    span = block + 2 * half
    kp = jnp.pad(k, ((0, 0), (half, half), (0, 0)))
    vp = jnp.pad(v, ((0, 0), (half, half), (0, 0)))
    idx = jnp.arange(nb)[:, None] * block + jnp.arange(span)[None, :]
    kb = kp[:, idx]
    vb = vp[:, idx]
    qb = q.reshape(n, g, nb, block, dh)
    s = jnp.einsum('ngbqd,nbkd->ngbqk', qb, kb).astype(jnp.float32) * (dh ** -0.5)
    qpos = jnp.arange(nb)[:, None] * block + jnp.arange(block)[None, :]
    kpos = idx - half
    valid = ((jnp.abs(qpos[:, :, None] - kpos[:, None, :]) <= half)
             & (kpos >= 0)[:, None, :] & (kpos < length)[:, None, :])
    s = jnp.where(valid, s, NEG_INF)
    lse = jax.nn.logsumexp(s, axis=-1)
    p = jnp.exp(s - lse[..., None]).astype(v.dtype)
    o = jnp.einsum('ngbqk,nbkd->ngbqd', p, vb)
    return o.reshape(n, g, length, dh), lse.reshape(n, g, length)


def to_strided(x, r):
    b, h, t, d = x.shape
    return x.reshape(b, h, t // r, r, d).transpose(0, 1, 3, 2, 4).reshape(b * h * r, t // r, d)


def from_strided(x, b, h, r):
    length = x.shape[1]
    rest = x.shape[2:]
    y = x.reshape((b, h, r, length) + rest)
    y = jnp.moveaxis(y, 2, 3)
    return y.reshape((b, h, length * r) + rest)


def dilated_attention(q, k, v):
    b, h, t, dh = q.shape
    outs, lses = [], []
    for window, r in DILATED_CONFIGS:
        length = t // r
        half = window // (2 * r)
        block = math.gcd(length, DILATED_BLOCK)
        o, lse = banded_attention(to_strided(q, r)[:, None], to_strided(k, r), to_strided(v, r), half, block)
        outs.append(from_strided(o[:, 0], b, h, r))
        lses.append(from_strided(lse[:, 0], b, h, r))
    weights = jax.nn.softmax(jnp.stack(lses), axis=0)
    return jnp.einsum('cbht,cbhtd->bhtd', weights.astype(q.dtype), jnp.stack(outs))


def sink_window_attention(q, k, v, sink):
    b, hq, t, dh = q.shape
    g = hq // N_KV_B
    o, lse = banded_attention(q.reshape(b * N_KV_B, g, t, dh), k.reshape(b * N_KV_B, t, dh),
                              v.reshape(b * N_KV_B, t, dh), WINDOW_B, BLOCK_B)
    sink_g = jnp.tile(sink.astype(jnp.float32).reshape(N_KV_B, g), (b, 1))[:, :, None]
    keep = jnp.exp(lse - jnp.logaddexp(lse, sink_g))
    return (o * keep[..., None].astype(o.dtype)).reshape(b, hq, t, dh)


def neighborhood_attention(q, k, v, rpb):
    b, h, t, dh = q.shape
    rows = t // GRID_W
    kr = min(NA_ROWS, rows)
    kc = NA_COLS
    r = jnp.arange(rows)
    c = jnp.arange(GRID_W)
    row_start = jnp.clip(r - kr // 2, 0, rows - kr)
    ridx = row_start[:, None] + jnp.arange(kr)[None, :]
    col_start = jnp.clip(c - kc // 2, 0, GRID_W - kc)
    col_mask = (c[None, :] >= col_start[:, None]) & (c[None, :] < col_start[:, None] + kc)
    qg = q.reshape(b, h, rows, GRID_W, dh)
    kg = k.reshape(b, h, rows, GRID_W, dh)[:, :, ridx]
    vg = v.reshape(b, h, rows, GRID_W, dh)[:, :, ridx]
    s = jnp.einsum('bhrcd,bhrkwd->bhrckw', qg, kg).astype(jnp.float32) * (dh ** -0.5)
    roff = (ridx - r[:, None]) + (NA_ROWS - 1)
    coff = jnp.clip(c[None, :] - c[:, None] + (kc - 1), 0, 2 * kc - 2)
    bias = rpb[:, roff[:, None, :, None], coff[None, :, None, :]]
    s = jnp.where(col_mask[:, None, :], s + bias.astype(jnp.float32)[None], NEG_INF)
    p = jax.nn.softmax(s.reshape(b, h, rows, GRID_W, kr * GRID_W), axis=-1)
    p = p.reshape(s.shape).astype(v.dtype)
    o = jnp.einsum('bhrckw,bhrkwd->bhrcd', p, vg)
    return o.reshape(b, h, t, dh)


def split_projection(proj):
    sizes = (WIDTH_A,) * 3 + (WIDTH_B, WIDTH_B_KV, WIDTH_B_KV) + (WIDTH_C,) * 3
    offsets = np.cumsum(sizes)[:-1].tolist()
    return jnp.split(proj, offsets, axis=-1)


def depthwise_conv(u, w, bias):
    t = u.shape[1]
    pad = CONV_WIDTH // 2
    up = jnp.pad(u, ((0, 0), (pad, pad), (0, 0)))
    return sum(up[:, j:j + t] * w[j] for j in range(CONV_WIDTH)) + bias


def setup_inputs(seed: int = 0) -> dict:
    key = jax.random.key(seed)
    ks = jax.random.split(key, 13)
    nrm = jax.random.normal
    f32 = jnp.float32
    return {
        'x': nrm(ks[0], (BATCH, SEQ, D_MODEL), f32),
        'ln_attn': 1.0 + 0.02 * nrm(ks[1], (DEPTH, D_MODEL), f32),
        'w_in': nrm(ks[2], (DEPTH, D_MODEL, IN_COLS), f32) * D_MODEL ** -0.5,
        'sink_b': 0.5 * nrm(ks[3], (DEPTH, N_HEADS_B), f32),
        'rpb_c': 0.1 * nrm(ks[4], (DEPTH, N_HEADS_C, 2 * NA_ROWS - 1, 2 * NA_COLS - 1), f32),
        'mix_gain': 1.0 + 0.02 * nrm(ks[5], (DEPTH, MIX_WIDTH), f32),
        'w_out': nrm(ks[6], (DEPTH, MIX_WIDTH, D_MODEL), f32) * MIX_WIDTH ** -0.5,
        'ln_ffn': 1.0 + 0.02 * nrm(ks[7], (DEPTH, D_MODEL), f32),
        'w_up': nrm(ks[8], (DEPTH, D_MODEL, 2 * D_FF), f32) * D_MODEL ** -0.5,
        'conv_w': nrm(ks[9], (DEPTH, CONV_WIDTH, 2 * D_FF), f32) * CONV_WIDTH ** -0.5,
        'conv_b': 0.01 * nrm(ks[10], (DEPTH, 2 * D_FF), f32),
        'w_down': nrm(ks[11], (DEPTH, D_FF, D_MODEL), f32) * D_FF ** -0.5,
        'ln_final': 1.0 + 0.02 * nrm(ks[12], (D_MODEL,), f32),
    }


def reference(x, ln_attn, w_in, sink_b, rpb_c, mix_gain, w_out, ln_ffn, w_up, conv_w, conv_b, w_down, ln_final):
    for l in range(DEPTH):
        h = rmsnorm(x, ln_attn[l])
        qa, ka, va, qb, kb, vb, qc, kc, vc = split_projection(h @ w_in[l])
        oa = dilated_attention(rotary(heads(qa, N_HEADS_A)), rotary(heads(ka, N_HEADS_A)), heads(va, N_HEADS_A))
        ob = sink_window_attention(rotary(heads(qb, N_HEADS_B)), rotary(heads(kb, N_KV_B)), heads(vb, N_KV_B), sink_b[l])
        oc = neighborhood_attention(heads(qc, N_HEADS_C), heads(kc, N_HEADS_C), heads(vc, N_HEADS_C), rpb_c[l])
        mixed = jnp.concatenate([rms_normalize(merge_heads(oa)), rms_normalize(merge_heads(ob)),
                                 rms_normalize(merge_heads(oc))], axis=-1) * mix_gain[l]
        x = x + mixed @ w_out[l]
        h = rmsnorm(x, ln_ffn[l])
        u = depthwise_conv(h @ w_up[l], conv_w[l], conv_b[l])
        gate, val = jnp.split(u, 2, axis=-1)
        x = x + (jax.nn.silu(gate) * val) @ w_down[l]
    return rmsnorm(x, ln_final)
```

```cpp
#include <hip/hip_runtime.h>
#include <hip/hip_cooperative_groups.h>
#include <cstdio>
#include <cstdint>
namespace cg = cooperative_groups;
namespace pg8 {
#define PG8_LAS __attribute__((address_space(3)))
typedef unsigned short bf16_t;
typedef short bf16x8 __attribute__((ext_vector_type(8)));
typedef float f32x4 __attribute__((ext_vector_type(4)));
typedef unsigned u32x4 __attribute__((ext_vector_type(4)));
constexpr int BM = 256, BK = 64, HALF = 128, HTB = HALF * BK * 2  , STAGE_BYTES = 8 * HTB, NXCD = 8, WGM = 8;

__host__ __device__ __forceinline__ int lds_byte(int r, int c) { const int st = (r >> 4) * 2 + (c >> 5), rr = r & 15, cc = c & 31, ob = rr * 64 + cc * 2; return st * 1024 + (ob ^ (((ob >> 9) & 1) << 5)); }
__host__ __device__ __forceinline__ void stage_rc(int b, int& R, int& C) { const int st = b / 1024, sb = b % 1024, swz = sb ^ (((sb >> 9) & 1) << 5); R = (st >> 1) * 16 + swz / 64; C = (st & 1) * 32 + (swz % 64) / 2; }
__host__ __device__ __forceinline__ int perm32(int rho) { const int n = rho >> 4, i = rho & 15; return 8 * (i >> 2) + 4 * n + (i & 3); }

struct Unit { int pm, pn; };
struct Gemm { const bf16_t* A; const bf16_t* Bt; int M, N, K; };

struct StaticOrder {
    int nM, nN, nwg, G, c; bool uneven;
    __host__ __device__ void init(int M, int N, int G_, int c_, bool uneven_ = false) { nM = M / BM; nN = N / BM; nwg = nM * nN; G = G_; c = c_; uneven = uneven_ && (G_ == 256); }
    __host__ __device__ bool next(int i, Unit& u) const {
        int wgid;
        if (uneven) { const int q = nwg / NXCD, xcd = c % NXCD, j = c / NXCD, RF = nwg / 256 - 1; int off;
            if (i < RF) off = i * 32 + j; else { if ((j & 1) || i >= RF + 2) return false; off = RF * 32 + (i - RF) * 16 + (j >> 1); }
            wgid = xcd * q + off;
        } else {
            const long L = (long)i * G + c; if (L >= nwg) return false;
            wgid = (int)L; { const int q = nwg / NXCD, r = nwg % NXCD, xcd = wgid % NXCD, off = wgid / NXCD; wgid = (xcd < r ? xcd * (q + 1) : r * (q + 1) + (xcd - r) * q) + off; }
        }
        const int nig = WGM * nN, gid = wgid / nig, fm = gid * WGM, gsz = (nM - fm) < WGM ? (nM - fm) : WGM;
        u.pm = fm + ((wgid % nig) % gsz); u.pn = (wgid % nig) / gsz; return true;
    }
    __device__ __forceinline__ void a_ready(const Unit&) const {}
    __device__ __forceinline__ void done(const Unit&) const {}
};

__device__ __forceinline__ unsigned cvt_pk_bf16(float lo, float hi) { unsigned r; asm volatile("v_cvt_pk_bf16_f32 %0, %1, %2" : "=v"(r) : "v"(lo), "v"(hi)); return r; }
typedef float f32x2 __attribute__((ext_vector_type(2)));
typedef unsigned u32x2 __attribute__((ext_vector_type(2)));
typedef __bf16 bf16x2_t __attribute__((ext_vector_type(2)));
__device__ __forceinline__ unsigned pk_bf16(float lo, float hi) { f32x2 v = {lo, hi}; bf16x2_t b = __builtin_convertvector(v, bf16x2_t); return __builtin_bit_cast(unsigned, b); }
constexpr float RMS_EPS = 1e-6f;

#define LAS3 __attribute__((address_space(3)))
__device__ __forceinline__ void ssp_prefetch(const float* ssp, int pm, LAS3 float* sspl, int wid, int lane) {
    const float* gp = ssp + ((size_t)(pm * BM + 32 * wid + (lane >> 1)) * 8 + (lane & 1) * 4);
    __builtin_amdgcn_global_load_lds((const unsigned*)gp, (LAS3 unsigned*)(sspl + wid * 256), 16, 0, 0);
}
__device__ __forceinline__ void rs_table_from_lds(const LAS3 float* sspl, LAS3 float* rsl, int tid) {
    const int r = tid >> 1, hf = tid & 1; const f32x4 a = *(const LAS3 f32x4*)(sspl + r * 8 + hf * 4);
    float sum = (a[0] + a[1]) + (a[2] + a[3]); sum += __shfl_xor(sum, 1);
    if (hf == 0) rsl[r] = __builtin_amdgcn_rsqf(sum * (1.0f / 2048.0f) + RMS_EPS);
}
#define PG8_LDS_BAR() do { asm volatile("s_waitcnt lgkmcnt(0)" ::: "memory"); __builtin_amdgcn_s_barrier(); asm volatile("" ::: "memory"); } while (0)

struct EpiInProj {
    static constexpr bool PERM = true, AFTER_DRAIN = false;
    bf16_t* O; const float* ssp; LAS3 float* sspl0; LAS3 float* rsl;
    __device__ __forceinline__ void prefetch(const Unit& u, int par, int wid, int lane) const { ssp_prefetch(ssp, u.pm, sspl0 + par * 2048, wid, lane); }
    __device__ __forceinline__ void operator()(const f32x4 (&acc)[2][2][4][2], const Unit& u, int wr, int wc, int fr, int fq, int par) const {
        const LAS3 float* sspl = sspl0 + par * 2048;
        const int row0 = u.pm * BM + wr * 64 + fr, col0 = u.pn * BM + wc * 32 + 8 * fq;
        const bool rot = (u.pn < 6) || (u.pn >= 9 && u.pn < 12);
        rs_table_from_lds(sspl, rsl, (wr * 4 + wc) * 64 + fq * 16 + fr); PG8_LDS_BAR();
        float rs[2][4];
#pragma unroll
        for (int ai = 0; ai < 2; ++ai)
#pragma unroll
            for (int m = 0; m < 4; ++m) rs[ai][m] = rsl[wr * 64 + fr + ai * HALF + m * 16];
        float sc[2];
#pragma unroll
        for (int bj = 0; bj < 2; ++bj) { const int cb = u.pn * BM + bj * HALF; const bool isq = (cb < 768) || (cb >= 2304 && cb < 2944) || (cb >= 3200 && cb < 3840); sc[bj] = isq ? 0.125f * 1.4426950408889634f : 1.0f; }
        float frev[2][2];
#pragma unroll
        for (int n = 0; n < 2; ++n)
#pragma unroll
            for (int p = 0; p < 2; ++p) { const int i = 16 * (wc & 1) + 4 * fq + 2 * n + p; frev[n][p] = __builtin_amdgcn_exp2f(-(float)i * (13.287712379549449f / 32.0f)) * 0.15915494309189535f; }
#pragma unroll
        for (int ai = 0; ai < 2; ++ai)
#pragma unroll
            for (int m = 0; m < 4; ++m) { const int row = row0 + ai * HALF + m * 16; const float rsv = rs[ai][m];
                bf16_t* rowp = O + (size_t)row * 5120 + col0; const float tpos = (float)(row & 2047);
                f32x4 r4[2] = {{1.f, 0.f, 1.f, 0.f}, {1.f, 0.f, 1.f, 0.f}};
                if (rot) {
#pragma unroll
                    for (int n = 0; n < 2; ++n)
#pragma unroll
                        for (int p = 0; p < 2; ++p) { const float rev = __builtin_amdgcn_fractf(tpos * frev[n][p]); r4[n][2 * p] = __builtin_amdgcn_cosf(rev); r4[n][2 * p + 1] = __builtin_amdgcn_sinf(rev); } }
#pragma unroll
                for (int bj = 0; bj < 2; ++bj) { f32x4 v[2]; const float s2 = rsv * sc[bj];
#pragma unroll
                    for (int n = 0; n < 2; ++n) { const f32x4 a = acc[ai][bj][m][n] * s2;
                        if (rot) { const f32x4 c = r4[n]; f32x4 o; o[0] = a[0] * c[0] - a[1] * c[1]; o[1] = a[1] * c[0] + a[0] * c[1]; o[2] = a[2] * c[2] - a[3] * c[3]; o[3] = a[3] * c[2] + a[2] * c[3]; v[n] = o; }
                        else v[n] = a; }
                    u32x4 w; w.x = pk_bf16(v[0][0], v[0][1]); w.y = pk_bf16(v[0][2], v[0][3]); w.z = pk_bf16(v[1][0], v[1][1]); w.w = pk_bf16(v[1][2], v[1][3]);
                    *(u32x4*)(rowp + bj * HALF) = w; } }
    }
};
struct EpiResid {
    static constexpr bool PERM = true, AFTER_DRAIN = false;
    bf16_t* xb; float* ss; LAS3 float* part  ;
    __device__ __forceinline__ void prefetch(const Unit&, int, int, int) const {}
    __device__ __forceinline__ void operator()(const f32x4 (&acc)[2][2][4][2], const Unit& u, int wr, int wc, int fr, int fq, int) const {
        const int row0 = u.pm * BM + wr * 64 + fr, col0 = u.pn * BM + wc * 32 + 8 * fq;
        u32x4 bq[2][2][2];
#define RES_LOAD(q_, slot_) do { _Pragma("unroll") for (int mm = 0; mm < 2; ++mm) _Pragma("unroll") for (int bj = 0; bj < 2; ++bj) \
            bq[slot_][mm][bj] = *(const u32x4*)(xb + (size_t)(row0 + ((q_) >> 1) * HALF + (2 * ((q_) & 1) + mm) * 16) * 2048 + col0 + bj * HALF); } while (0)
        RES_LOAD(0, 0);
#pragma unroll
        for (int q = 0; q < 4; ++q) { const int ai = q >> 1, slot = q & 1;
            if (q + 1 < 4) RES_LOAD(q + 1, (q + 1) & 1);
#pragma unroll
            for (int mm = 0; mm < 2; ++mm) { const int m = 2 * (q & 1) + mm, row = row0 + ai * HALF + m * 16; bf16_t* rowp = xb + (size_t)row * 2048 + col0; float sq = 0.f;
#pragma unroll
                for (int bj = 0; bj < 2; ++bj) { const u32x4 b = bq[slot][mm][bj]; const f32x4 a0 = acc[ai][bj][m][0], a1 = acc[ai][bj][m][1];
                    float o[8];
                    o[0] = __uint_as_float(b.x << 16) + a0[0]; o[1] = __uint_as_float(b.x & 0xffff0000u) + a0[1]; o[2] = __uint_as_float(b.y << 16) + a0[2]; o[3] = __uint_as_float(b.y & 0xffff0000u) + a0[3];
                    o[4] = __uint_as_float(b.z << 16) + a1[0]; o[5] = __uint_as_float(b.z & 0xffff0000u) + a1[1]; o[6] = __uint_as_float(b.w << 16) + a1[2]; o[7] = __uint_as_float(b.w & 0xffff0000u) + a1[3];
#pragma unroll
                    for (int e = 0; e < 8; ++e) sq += o[e] * o[e];
                    u32x4 w; w.x = pk_bf16(o[0], o[1]); w.y = pk_bf16(o[2], o[3]); w.z = pk_bf16(o[4], o[5]); w.w = pk_bf16(o[6], o[7]);
                    *(u32x4*)(rowp + bj * HALF) = w; }
                sq += __shfl_xor(sq, 16); sq += __shfl_xor(sq, 32);
                if (fq == 0) part[wc * 256 + (row - u.pm * BM)] = sq; }
            asm volatile("" ::: "memory"); }
#undef RES_LOAD
        PG8_LDS_BAR();
        { const int tid = (wr * 4 + wc) * 64 + fq * 16 + fr; if (tid < 256) ss[(size_t)(u.pm * BM + tid) * 8 + u.pn] = (part[tid] + part[256 + tid]) + (part[512 + tid] + part[768 + tid]); }
    }
};
__device__ __forceinline__ float dpp_f(float oldv, float src, int ctrl_sel) {
    const int o = __float_as_int(oldv), s = __float_as_int(src); int r;
    if (ctrl_sel == 0) r = __builtin_amdgcn_update_dpp(o, s, 0x111, 0xF, 0xF, false);
    else if (ctrl_sel == 1) r = __builtin_amdgcn_update_dpp(o, s, 0x101, 0xF, 0xF, false);
    else if (ctrl_sel == 2) r = __builtin_amdgcn_mov_dpp(s, 0x121, 0xF, 0xF, true);
    else r = __builtin_amdgcn_mov_dpp(s, 0x12F, 0xF, 0xF, true);
    return __int_as_float(r);
}
__device__ __forceinline__ f32x4 dpp4(const f32x4& oldv, const f32x4& src, int sel) { f32x4 r; r[0] = dpp_f(oldv[0], src[0], sel); r[1] = dpp_f(oldv[1], src[1], sel); r[2] = dpp_f(oldv[2], src[2], sel); r[3] = dpp_f(oldv[3], src[3], sel); return r; }
struct EpiUpConv {
    static constexpr bool PERM = true, AFTER_DRAIN = false;
    bf16_t* G; const float* ssp; const float* cw  ; float* epart; float* eraw; LAS3 float* xch  ; LAS3 float* rsl; LAS3 float* sspl0  ; LAS3 float* tapl0  ;
    __device__ __forceinline__ void prefetch(const Unit& u, int par, int wid, int lane) const { ssp_prefetch(ssp, u.pm, sspl0 + par * 2048, wid, lane);
        if (wid < 4) __builtin_amdgcn_global_load_lds((const unsigned*)(cw + (size_t)wid * 11264 + u.pn * BM + lane * 4), (LAS3 unsigned*)(tapl0 + par * 1024 + wid * 256), 16, 0, 0); }
    __device__ __forceinline__ void operator()(const f32x4 (&acc)[2][2][4][2], const Unit& u, int wr, int wc, int fr, int fq, int par) const {
        const LAS3 float* sspl = sspl0 + par * 2048; const LAS3 float* tapl = tapl0 + par * 1024;
        const int row0 = u.pm * BM + wr * 64 + fr, jcol = wc * 32 + 8 * fq, ncol = u.pn * BM + jcol;
        rs_table_from_lds(sspl, rsl, (wr * 4 + wc) * 64 + fq * 16 + fr);
#pragma unroll
        for (int ai = 0; ai < 2; ++ai) { const int s = 2 * ai + wr;
            if (fr == 0 && s > 0) {
#pragma unroll
                for (int bj = 0; bj < 2; ++bj)
#pragma unroll
                    for (int n = 0; n < 2; ++n) *(LAS3 f32x4*)(xch + (s * 2 - 1) * 256 + 128 * bj + jcol + 4 * n) = acc[ai][bj][0][n]; }
            if (fr == 15 && s < 3) {
#pragma unroll
                for (int bj = 0; bj < 2; ++bj)
#pragma unroll
                    for (int n = 0; n < 2; ++n) *(LAS3 f32x4*)(xch + (s * 2) * 256 + 128 * bj + jcol + 4 * n) = acc[ai][bj][3][n]; } }
        PG8_LDS_BAR();
        float rs[2][4];
#pragma unroll
        for (int ai = 0; ai < 2; ++ai)
#pragma unroll
            for (int m = 0; m < 4; ++m) rs[ai][m] = rsl[wr * 64 + fr + ai * HALF + m * 16];
        const f32x4 zero4 = {0.f, 0.f, 0.f, 0.f};
#pragma unroll
        for (int n = 0; n < 2; ++n) {
            f32x4 w0[2], w1[2], w2[2], bb[2];
#pragma unroll
            for (int bj = 0; bj < 2; ++bj) { const LAS3 float* p = tapl + 128 * bj + jcol + 4 * n; w0[bj] = *(const LAS3 f32x4*)(p); w1[bj] = *(const LAS3 f32x4*)(p + 256); w2[bj] = *(const LAS3 f32x4*)(p + 512); bb[bj] = *(const LAS3 f32x4*)(p + 768); }
#pragma unroll
            for (int ai = 0; ai < 2; ++ai) { const int s = 2 * ai + wr;
#pragma unroll
                for (int m = 0; m < 4; ++m) { f32x4 uu[2];
#pragma unroll
                    for (int bj = 0; bj < 2; ++bj) { const f32x4 x = acc[ai][bj][m][n] * rs[ai][m];
                        f32x4 fp, fn;
                        if (m > 0) { const f32x4 xm = acc[ai][bj][m > 0 ? m - 1 : 0][n] * rs[ai][m > 0 ? m - 1 : 0]; fp = dpp4(xm, xm, 2); }
                        else fp = (s > 0) ? *(const LAS3 f32x4*)(xch + (s > 0 ? 2 * s - 2 : 0) * 256 + 128 * bj + jcol + 4 * n) * rsl[s > 0 ? 64 * s - 1 : 0] : zero4;
                        if (m < 3) { const f32x4 xp = acc[ai][bj][m < 3 ? m + 1 : 3][n] * rs[ai][m < 3 ? m + 1 : 3]; fn = dpp4(xp, xp, 3); }
                        else fn = (s < 3) ? *(const LAS3 f32x4*)(xch + (s < 3 ? 2 * s + 1 : 0) * 256 + 128 * bj + jcol + 4 * n) * rsl[s < 3 ? 64 * (s + 1) : 0] : zero4;
                        const f32x4 p = dpp4(fp, x, 0), q = dpp4(fn, x, 1);
                        uu[bj] = bb[bj] + w0[bj] * p + w1[bj] * x + w2[bj] * q;
                        if (ai == 0 && m == 0) { if (wr == 0 && fr == 0) { const size_t o = (size_t)(u.pm * 2 + 0) * 11264 + ncol + 128 * bj + 4 * n; *(f32x4*)(epart + o) = uu[bj]; *(f32x4*)(eraw + o) = x; } }
                        if (ai == 1 && m == 3) { if (wr == 1 && fr == 15) { const size_t o = (size_t)(u.pm * 2 + 1) * 11264 + ncol + 128 * bj + 4 * n; *(f32x4*)(epart + o) = uu[bj]; *(f32x4*)(eraw + o) = x; } }
                    }
                    float gg[4];
#pragma unroll
                    for (int e = 0; e < 4; ++e) { const float xg = uu[0][e]; gg[e] = xg * __builtin_amdgcn_rcpf(1.0f + __builtin_amdgcn_exp2f(-1.4426950408889634f * xg)) * uu[1][e]; }
                    u32x2 w; w.x = pk_bf16(gg[0], gg[1]); w.y = pk_bf16(gg[2], gg[3]);
                    *(u32x2*)(G + (size_t)(row0 + ai * HALF + m * 16) * 5632 + u.pn * 128 + jcol + 4 * n) = w;
                    __builtin_amdgcn_sched_barrier(0);
                }
            }
        }
    }
};
template <class Epi, class Sched, bool ALIGN_EPI = false, bool SP2 = false>
__device__ __forceinline__ void gemm_phase(PG8_LAS unsigned char* lds, const Gemm g, const Sched& S, const Epi& E) {
    int tid_ = threadIdx.x; asm volatile("" : "+v"(tid_));
    const int tid = tid_, wid = __builtin_amdgcn_readfirstlane(tid >> 6), lane = tid & 63, wr = wid >> 2, wc = wid & 3, fr = lane & 15, fq = lane >> 4;
    const int K = g.K, nt = K / BK;
    unsigned voffA[2], voffB[2];
#pragma unroll
    for (int i = 0; i < 2; ++i) { int R, C; stage_rc(tid * 16 + i * 8192, R, C); const int Rb = Epi::PERM ? ((R & ~31) + perm32(R & 31)) : R;
        voffA[i] = (unsigned)(R * K + C) * 2u; voffB[i] = (unsigned)(Rb * K + C) * 2u; }
    const size_t kstep = (size_t)(BK * 2);
    const size_t hstep = (size_t)HALF * K * 2;
    const size_t tstep = 2 * hstep;
    const unsigned ldsw = (unsigned)wid * 1024u;
    const int aoff = lds_byte(wr * 64 + fr, fq * 8), boff = lds_byte(wc * 32 + fr, fq * 8);
#define PG8_SA(b, h) (((b) * 2 + (h)) * HTB)
#define PG8_SB(b, h) ((4 + (b) * 2 + (h)) * HTB)
#define PG8_STAGE(bufoff, gbase, voff) do { _Pragma("unroll") for (int _i = 0; _i < 2; ++_i) \
        __builtin_amdgcn_global_load_lds((const unsigned*)((const char*)(gbase) + (voff)[_i]), (PG8_LAS unsigned*)(lds + (bufoff) + ldsw + _i * 8192), 16, 0, 0); } while (0)
#define PG8_LDA(dst, b, h) do { _Pragma("unroll") for (int m = 0; m < 4; ++m) _Pragma("unroll") for (int k = 0; k < 2; ++k) dst[m][k] = *(const PG8_LAS bf16x8*)(lds + PG8_SA(b, h) + aoff + m * 2048 + k * 1024); } while (0)
#define PG8_LDB(dst, b, h) do { _Pragma("unroll") for (int n = 0; n < 2; ++n) _Pragma("unroll") for (int k = 0; k < 2; ++k) dst[n][k] = *(const PG8_LAS bf16x8*)(lds + PG8_SB(b, h) + boff + n * 2048 + k * 1024); } while (0)
#define PG8_MMA(ai, bj, At, Bt) do { __builtin_amdgcn_s_setprio(1); _Pragma("unroll") for (int m = 0; m < 4; ++m) _Pragma("unroll") for (int n = 0; n < 2; ++n) _Pragma("unroll") for (int k = 0; k < 2; ++k) \
        acc[ai][bj][m][n] = __builtin_amdgcn_mfma_f32_16x16x32_bf16(Bt[n][k], At[m][k], acc[ai][bj][m][n], 0, 0, 0); __builtin_amdgcn_s_setprio(0); } while (0)
#define PG8_WAIT_V(n) asm volatile("s_waitcnt vmcnt(" #n ")" ::: "memory")
#define PG8_WAIT_L(n) asm volatile("s_waitcnt lgkmcnt(" #n ")" ::: "memory")
#define PG8_BAR __builtin_amdgcn_s_barrier()
#define PG8_SCHED __builtin_amdgcn_sched_barrier(0)
    Unit cur, nxt; int ui = 0;
    if (!S.next(0, cur)) return;
    f32x4 acc[2][2][4][2];
#pragma unroll
    for (int a = 0; a < 2; ++a)
#pragma unroll
        for (int b = 0; b < 2; ++b)
#pragma unroll
            for (int m = 0; m < 4; ++m)
#pragma unroll
                for (int n = 0; n < 2; ++n) acc[a][b][m][n] = (f32x4){0.f, 0.f, 0.f, 0.f};
    bf16x8 At[4][2], B0[2][2], B1[2][2];
    const char* cA = (const char*)g.A + (size_t)cur.pm * tstep; const char* cB = (const char*)g.Bt + (size_t)cur.pn * tstep;
    S.a_ready(cur);
    E.prefetch(cur, 0, wid, lane);
    if constexpr (SP2) {
        PG8_STAGE(PG8_SB(0, 0), cB, voffB); PG8_STAGE(PG8_SB(0, 1), cB + hstep, voffB); PG8_STAGE(PG8_SA(0, 0), cA, voffA); PG8_STAGE(PG8_SA(0, 1), cA + hstep, voffA);
        if (wr == 1) PG8_BAR;
        PG8_WAIT_V(2); PG8_BAR;
        PG8_STAGE(PG8_SB(1, 0), cB + kstep, voffB); PG8_STAGE(PG8_SA(1, 0), cA + kstep, voffA); PG8_STAGE(PG8_SB(1, 1), cB + hstep + kstep, voffB);
        PG8_WAIT_V(6); PG8_BAR;
    } else {
        PG8_STAGE(PG8_SB(0, 0), cB, voffB); PG8_STAGE(PG8_SA(0, 0), cA, voffA); PG8_STAGE(PG8_SB(0, 1), cB + hstep, voffB); PG8_STAGE(PG8_SA(0, 1), cA + hstep, voffA);
        if (wr == 1) PG8_BAR;
        PG8_WAIT_V(4); PG8_BAR;
        PG8_STAGE(PG8_SB(1, 0), cB + kstep, voffB); PG8_STAGE(PG8_SA(1, 0), cA + kstep, voffA); PG8_STAGE(PG8_SB(1, 1), cB + hstep + kstep, voffB);
        PG8_WAIT_V(6); PG8_BAR;
    }
    for (;;) {
        const bool has_next = S.next(ui + 1, nxt);
        const char* nA = has_next ? (const char*)g.A + (size_t)nxt.pm * tstep : cA; const char* nB = has_next ? (const char*)g.Bt + (size_t)nxt.pn * tstep : cB;
        for (int t = 0; t < nt; t += 2) {
            const bool last = (t == nt - 2);
            const char* a1 = cA + (size_t)(t + 1) * kstep;
            const char* a2 = last ? nA : cA + (size_t)(t + 2) * kstep; const char* b2 = last ? nB : cB + (size_t)(t + 2) * kstep;
            const char* a3 = a2 + kstep; const char* b3 = b2 + kstep;
            if (last && has_next) S.a_ready(nxt);
            if constexpr (SP2) {
            PG8_LDB(B0, 0, 0); PG8_LDB(B1, 0, 1); PG8_SCHED; PG8_LDA(At, 0, 0); PG8_STAGE(PG8_SA(1, 1), a1 + hstep, voffA);
            PG8_WAIT_V(8); PG8_WAIT_L(0); PG8_BAR; PG8_MMA(0, 0, At, B0); PG8_MMA(0, 1, At, B1); PG8_BAR; PG8_SCHED;
            PG8_LDA(At, 0, 1); PG8_STAGE(PG8_SB(0, 0), b2, voffB); PG8_STAGE(PG8_SB(0, 1), b2 + hstep, voffB); PG8_STAGE(PG8_SA(0, 0), a2, voffA);
            PG8_WAIT_V(8); PG8_WAIT_L(0); PG8_BAR; PG8_MMA(1, 0, At, B0); PG8_MMA(1, 1, At, B1); PG8_BAR; PG8_SCHED;
            PG8_LDB(B0, 1, 0); PG8_LDB(B1, 1, 1); PG8_SCHED; PG8_LDA(At, 1, 0); PG8_STAGE(PG8_SA(0, 1), a2 + hstep, voffA);
            PG8_WAIT_V(8); PG8_WAIT_L(0); PG8_BAR; PG8_MMA(0, 0, At, B0); PG8_MMA(0, 1, At, B1); PG8_BAR; PG8_SCHED;
            PG8_LDA(At, 1, 1); PG8_STAGE(PG8_SB(1, 0), b3, voffB); PG8_STAGE(PG8_SB(1, 1), b3 + hstep, voffB); PG8_STAGE(PG8_SA(1, 0), a3, voffA);
            PG8_WAIT_V(8); PG8_WAIT_L(0); PG8_BAR; PG8_MMA(1, 0, At, B0); PG8_MMA(1, 1, At, B1); PG8_BAR; PG8_SCHED;
            } else {
            PG8_LDB(B0, 0, 0); PG8_SCHED; PG8_LDA(At, 0, 0); PG8_STAGE(PG8_SA(1, 1), a1 + hstep, voffA);
            PG8_WAIT_L(8); PG8_BAR; PG8_WAIT_L(0); PG8_MMA(0, 0, At, B0); PG8_BAR; PG8_SCHED;
            PG8_LDB(B1, 0, 1); PG8_STAGE(PG8_SB(0, 0), b2, voffB);
            PG8_BAR; PG8_WAIT_L(0); PG8_MMA(0, 1, At, B1); PG8_BAR;
            PG8_LDA(At, 0, 1); PG8_STAGE(PG8_SA(0, 0), a2, voffA);
            PG8_BAR; PG8_WAIT_L(0); PG8_MMA(1, 0, At, B0); PG8_BAR; PG8_SCHED;
            PG8_STAGE(PG8_SB(0, 1), b2 + hstep, voffB);
            PG8_WAIT_V(6); PG8_BAR; PG8_MMA(1, 1, At, B1); PG8_BAR;
            PG8_LDB(B0, 1, 0); PG8_SCHED; PG8_LDA(At, 1, 0); PG8_STAGE(PG8_SA(0, 1), a2 + hstep, voffA);
            PG8_WAIT_L(8); PG8_BAR; PG8_WAIT_L(0); PG8_MMA(0, 0, At, B0); PG8_BAR; PG8_SCHED;
            PG8_LDB(B1, 1, 1); PG8_STAGE(PG8_SB(1, 0), b3, voffB);
            PG8_BAR; PG8_WAIT_L(0); PG8_MMA(0, 1, At, B1); PG8_BAR;
            PG8_LDA(At, 1, 1); PG8_STAGE(PG8_SA(1, 0), a3, voffA);
            PG8_BAR; PG8_WAIT_L(0); PG8_MMA(1, 0, At, B0); PG8_BAR; PG8_SCHED;
            PG8_STAGE(PG8_SB(1, 1), b3 + hstep, voffB);
            PG8_WAIT_V(6); PG8_BAR; PG8_MMA(1, 1, At, B1); PG8_BAR;
            }
        }
        if constexpr (ALIGN_EPI) { if (wr == 0) PG8_BAR; }
        if constexpr (!Epi::AFTER_DRAIN) { E(acc, cur, wr, wc, fr, fq, ui & 1); S.done(cur); }
        if (!has_next) break;
#pragma unroll
        for (int a = 0; a < 2; ++a)
#pragma unroll
            for (int b = 0; b < 2; ++b)
#pragma unroll
                for (int m = 0; m < 4; ++m)
#pragma unroll
                    for (int n = 0; n < 2; ++n) acc[a][b][m][n] = (f32x4){0.f, 0.f, 0.f, 0.f};
        cur = nxt; cA = nA; cB = nB; ++ui;
        E.prefetch(cur, ui & 1, wid, lane);
        if constexpr (ALIGN_EPI) { if (wr == 1) PG8_BAR; }
    }
    PG8_WAIT_V(0);
    if constexpr (!ALIGN_EPI) { if (wr == 0) PG8_BAR; }
    PG8_BAR;
    if constexpr (Epi::AFTER_DRAIN) { E.fused(acc, cur, wr, wc, fr, fq, lds, wid, lane); S.done(cur); }
#undef PG8_SA
#undef PG8_SB
#undef PG8_STAGE
#undef PG8_LDA
#undef PG8_LDB
#undef PG8_MMA
#undef PG8_WAIT_V
#undef PG8_WAIT_L
#undef PG8_BAR
#undef PG8_SCHED
}
}

#define LAS __attribute__((address_space(3)))
#define GAS __attribute__((address_space(1)))
typedef unsigned short bf16_t;
typedef short bf16x8 __attribute__((ext_vector_type(8)));
typedef short s16x4 __attribute__((ext_vector_type(4)));
typedef float f32x4 __attribute__((ext_vector_type(4)));
typedef float f32x2 __attribute__((ext_vector_type(2)));
typedef float f32x16 __attribute__((ext_vector_type(16)));
typedef unsigned u32x4 __attribute__((ext_vector_type(4)));
typedef unsigned u32x2 __attribute__((ext_vector_type(2)));
using pg8::pk_bf16;

constexpr int NWAVES = 8, NTHREADS = 512;
constexpr int M = 16384, T = 2048, D = 2048, NIN = 5120, DFF = 5632, NUP = 11264;
constexpr int MH = M / 2;
constexpr float LOG2E = 1.4426950408889634f;
constexpr float EPS = 1e-6f;
constexpr size_t MiB = 1u << 20;
constexpr size_t WS_BAR = 448 * 1024;
constexpr size_t WS_AL = 2 * MiB;
constexpr size_t WS_CW = 5 * MiB;
constexpr size_t WS_WIN = 8 * MiB;
constexpr size_t WS_WOUT = 48 * MiB;
constexpr size_t WS_WUP = 64 * MiB;
constexpr size_t WS_WDOWN = 152 * MiB;
constexpr size_t WS_XB = 196 * MiB;
constexpr size_t WS_BIG = 260 * MiB;
constexpr size_t WS_PROJ = WS_BIG;
constexpr size_t WS_AO = WS_BIG + 160 * MiB;
constexpr size_t WS_MIX = WS_BIG + 232 * MiB;
constexpr size_t WS_EPART = WS_BIG;
constexpr size_t WS_ERAW = WS_BIG + 8 * MiB;
constexpr size_t WS_G = WS_BIG + 176 * MiB;
constexpr size_t WS_SSP = WS_BIG + 352 * MiB;
constexpr size_t WS_END = WS_SSP + 12 * MiB;
constexpr int LDS_BYTES = 163840;

__device__ __forceinline__ float bf2f(unsigned short b) { return __uint_as_float((unsigned)b << 16); }
__device__ __forceinline__ float bflo(unsigned w) { return __uint_as_float(w << 16); }
__device__ __forceinline__ float bfhi(unsigned w) { return __uint_as_float(w & 0xffff0000u); }
__device__ __forceinline__ float wave_sum(float v) {
#pragma unroll
    for (int o = 1; o < 64; o <<= 1) v += __shfl_xor(v, o);
    return v;
}

template <int MODE> __device__ __forceinline__ int dst_row(int n) {
    if (MODE == 1) { if (n < 1536 || (n >= 2304 && n < 3072)) { const int d = n & 63; return (n & ~63) + 2 * (d & 31) + (d >> 5); } return n; }
    if (MODE == 2) { const int p = n >= 5632 ? 1 : 0, n2 = n - 5632 * p; return 256 * (n2 >> 7) + 128 * p + (n2 & 127); }
    return n;
}
template <int MODE, bool HASGAIN = true> __device__ __forceinline__ void transpose_item(const float* W, int K, int N, bf16_t* WT, const float* gain, LAS unsigned* scr, int item, int lane) {
    const int nblk = N / 64, kb = item / nblk, nb = item % nblk, k0 = 64 * kb, n0 = 64 * nb;
    const int c4 = (lane & 15) * 4, pr = lane >> 4;
    f32x4 av[8], bv[8]; f32x2 gg[8];
    const float* p0 = W + (size_t)(k0 + 2 * pr) * N + n0 + c4;
#pragma unroll
    for (int i = 0; i < 8; ++i) { const float* p = p0 + (size_t)(8 * i) * N; av[i] = __builtin_nontemporal_load((const f32x4*)p); bv[i] = __builtin_nontemporal_load((const f32x4*)(p + N)); }
#pragma unroll
    for (int i = 0; i < 8; ++i) { if (HASGAIN) gg[i] = *(const f32x2*)(gain + k0 + 2 * (4 * i + pr)); else gg[i] = (f32x2){1.f, 1.f}; }
    asm volatile("" ::: "memory");
#pragma unroll
    for (int i = 0; i < 8; ++i) { const int kk2 = 4 * i + pr; const f32x4 a = av[i] * gg[i].x, b = bv[i] * gg[i].y;
        u32x2 lo, hi; lo.x = pk_bf16(a[0], b[0]); lo.y = pk_bf16(a[1], b[1]); hi.x = pk_bf16(a[2], b[2]); hi.y = pk_bf16(a[3], b[3]);
        *(LAS u32x2*)(scr + kk2 * 66 + c4) = lo; *(LAS u32x2*)(scr + kk2 * 66 + c4 + 2) = hi; }
    asm volatile("s_waitcnt lgkmcnt(0)" ::: "memory");
    const int c = lane & 7;
#pragma unroll
    for (int j = 0; j < 8; ++j) { const int n = (lane >> 3) + 8 * j; const LAS unsigned* q = scr + (4 * c) * 66 + n;
        u32x4 o; o.x = q[0]; o.y = q[66]; o.z = q[132]; o.w = q[198];
        *(u32x4*)(WT + (size_t)dst_row<MODE>(n0 + n) * K + k0 + 8 * c) = o; }
    asm volatile("s_waitcnt lgkmcnt(0)" ::: "memory");
}

constexpr int KSTR = 144;
constexpr int WAVE_LDS = 11264;
__device__ __forceinline__ int crow(int i, int h) { return (i & 3) + 8 * (i >> 2) + 4 * h; }

struct PolA {
    int tokbase, r, rho, jb, L;
    __device__ __forceinline__ int ntiles() const { return 5; }
    __device__ __forceinline__ bool tile_ok(int kt) const { const int j0 = jb - 64 + 32 * kt; return j0 >= 0 && j0 < L; }
    __device__ __forceinline__ int key_tok(int kt, int rowi) const { return tokbase + (jb - 64 + 32 * kt + rowi) * r + rho; }
    __device__ __forceinline__ int q_tok(int rq) const { return tokbase + (jb + rq) * r + rho; }
    __device__ __forceinline__ bool needs_mask(int kt) const { return kt == 0 || kt == 4; }
    __device__ __forceinline__ bool valid(int kt, int kv, int rq) const { const int d = 32 * kt - 64 + kv - rq; return (unsigned)(d + 64) <= 128u; }
    __device__ __forceinline__ float bias(int, int) const { return 0.f; }
};
struct PolB {
    int tokbase, q0;
    __device__ __forceinline__ int ntiles() const { return 9; }
    __device__ __forceinline__ bool tile_ok(int kt) const { const int t0 = q0 - 128 + 32 * kt; return t0 >= 0 && t0 < T; }
    __device__ __forceinline__ int key_tok(int kt, int rowi) const { return tokbase + q0 - 128 + 32 * kt + rowi; }
    __device__ __forceinline__ int q_tok(int rq) const { return tokbase + q0 + rq; }
    __device__ __forceinline__ bool needs_mask(int kt) const { return kt == 0 || kt == 8; }
    __device__ __forceinline__ bool valid(int kt, int kv, int rq) const { const int d = 32 * kt - 128 + kv - rq; return (unsigned)(d + 128) <= 256u; }
    __device__ __forceinline__ float bias(int, int) const { return 0.f; }
};
struct PolC {
    int tokbase, Rp, cb, rs0, kc0, nt;
    int Rq, c, rsq, csq;
    const LAS float* tab;
    __device__ __forceinline__ int ntiles() const { return nt; }
    __device__ __forceinline__ bool tile_ok(int kt) const { return rs0 + kt <= 31; }
    __device__ __forceinline__ int key_tok(int kt, int rowi) const { return tokbase + (rs0 + kt) * 64 + kc0 + rowi; }
    __device__ __forceinline__ int q_tok(int rq) const { return tokbase + (2 * Rp + (rq >> 4)) * 64 + 16 * cb + (rq & 15); }
    __device__ __forceinline__ bool needs_mask(int) const { return true; }
    __device__ __forceinline__ bool valid(int kt, int kv, int) const { const int kr = rs0 + kt; return (unsigned)(kr - rsq) < 8u && (unsigned)(kv + kc0 - csq) < 16u; }
    __device__ __forceinline__ float bias(int kt, int kv) const { const int idx = (rs0 + kt - Rq + 7) * 31 + (kc0 - c + 15) + kv; return tab[idx < 0 ? 0 : (idx > 464 ? 464 : idx)]; }
};

template <class Pol, bool HASBIAS> __device__ __forceinline__ void attn_tile(const Pol& P, int kt, LAS unsigned char* Kb, LAS unsigned char* Vb, const bf16x8 (&qf)[4], float& m, float& l, f32x16 (&o)[2], int lane) {
    const int r = lane & 31, h = lane >> 5;
    const int i16 = lane & 15, tq = i16 >> 2, tp = i16 & 3, blk = (lane >> 4) & 1;
    f32x16 s;
#pragma unroll
    for (int i = 0; i < 16; ++i) s[i] = 0.f;
#pragma unroll
    for (int ds = 0; ds < 4; ++ds) { const bf16x8 a = *(const LAS bf16x8*)(Kb + r * KSTR + ds * 32 + h * 16); s = __builtin_amdgcn_mfma_f32_32x32x16_bf16(a, qf[ds], s, 0, 0, 0); }
    float tm = -1e30f;
    if (P.needs_mask(kt)) {
#pragma unroll
        for (int i = 0; i < 16; ++i) { const int kv = crow(i, h); float v = s[i]; if (HASBIAS) v += P.bias(kt, kv); v = P.valid(kt, kv, r) ? v : -1e30f; s[i] = v; tm = fmaxf(tm, v); }
    } else {
#pragma unroll
        for (int i = 0; i < 16; ++i) tm = fmaxf(tm, s[i]);
    }
    tm = fmaxf(tm, __shfl_xor(tm, 32));
    if (__any(tm > m + 8.0f)) {

        const float mn = fmaxf(m, tm), alpha = __builtin_amdgcn_exp2f(m - mn); m = mn; l *= alpha;
#pragma unroll
        for (int i = 0; i < 16; ++i) { o[0][i] *= alpha; o[1][i] *= alpha; }
    }
    float ps = 0.f;
#pragma unroll
    for (int i = 0; i < 16; ++i) { s[i] = __builtin_amdgcn_exp2f(s[i] - m); ps += s[i]; }
    l += ps;
    bf16x8 pb[2];
#pragma unroll
    for (int s2 = 0; s2 < 2; ++s2) { u32x4 w; w.x = pk_bf16(s[8 * s2 + 0], s[8 * s2 + 1]); w.y = pk_bf16(s[8 * s2 + 2], s[8 * s2 + 3]); w.z = pk_bf16(s[8 * s2 + 4], s[8 * s2 + 5]); w.w = pk_bf16(s[8 * s2 + 6], s[8 * s2 + 7]); pb[s2] = __builtin_bit_cast(bf16x8, w); }
#pragma unroll
    for (int dt = 0; dt < 2; ++dt)
#pragma unroll
        for (int s2 = 0; s2 < 2; ++s2) {
            typedef short v4i16_t __attribute__((ext_vector_type(4)));
            LAS unsigned char* pa = Vb + (16 * s2 + 4 * h + tq) * KSTR + (32 * dt + 16 * blk) * 2 + 8 * tp;
            const s16x4 lo = __builtin_bit_cast(s16x4, __builtin_amdgcn_ds_read_tr16_b64_v4i16((LAS v4i16_t*)pa));
            const s16x4 hi = __builtin_bit_cast(s16x4, __builtin_amdgcn_ds_read_tr16_b64_v4i16((LAS v4i16_t*)(pa + 8 * KSTR)));
            const bf16x8 a = __builtin_shufflevector(lo, hi, 0, 1, 2, 3, 4, 5, 6, 7);
            o[dt] = __builtin_amdgcn_mfma_f32_32x32x16_bf16(a, pb[s2], o[dt], 0, 0, 0);
        }
}
template <class Pol, bool HASBIAS> __device__ __forceinline__ void attn_run(const Pol& P, LAS unsigned char* wl, const bf16_t* proj, int qcol, int kcol, int vcol, int lane, float& m_out, float& l_out, f32x16 (&o)[2]) {
    const int r = lane & 31, h = lane >> 5;
    const bf16_t* qp = proj + (size_t)P.q_tok(r) * NIN + qcol + 8 * h;
    bf16x8 qf[4];
#pragma unroll
    for (int ds = 0; ds < 4; ++ds) qf[ds] = *(const bf16x8*)(qp + 16 * ds);
    float m = -5e29f, l = 0.f;
#pragma unroll
    for (int i = 0; i < 16; ++i) { o[0][i] = 0.f; o[1][i] = 0.f; }
    const int srow = lane >> 3, sch = lane & 7;
    LAS unsigned char* Kb = wl; LAS unsigned char* Vb = wl + 4608;
    int lo = 0, hi = P.ntiles() - 1;
    while (lo <= hi && !P.tile_ok(lo)) ++lo;
    while (hi >= lo && !P.tile_ok(hi)) --hi;
    u32x4 ka[4], va[4], kb[4], vb[4];
#define ATT_LOAD(KR, VR, KT) do { _Pragma("unroll") for (int i = 0; i < 4; ++i) { const unsigned off = (unsigned)P.key_tok((KT), i * 8 + srow) * (unsigned)(NIN * 2) + (unsigned)(sch * 16); \
        KR[i] = *(const u32x4*)((const char*)proj + (off + (unsigned)(kcol * 2))); VR[i] = *(const u32x4*)((const char*)proj + (off + (unsigned)(vcol * 2))); } } while (0)
#define ATT_STEP(KR, VR, KT) do { _Pragma("unroll") for (int i = 0; i < 4; ++i) { *(LAS u32x4*)(Kb + (i * 8 + srow) * KSTR + sch * 16) = KR[i]; *(LAS u32x4*)(Vb + (i * 8 + srow) * KSTR + sch * 16) = VR[i]; } \
        if ((KT) + 2 <= hi) ATT_LOAD(KR, VR, (KT) + 2); \
        asm volatile("" ::: "memory"); attn_tile<Pol, HASBIAS>(P, (KT), Kb, Vb, qf, m, l, o, lane); asm volatile("" ::: "memory"); } while (0)
    if (lo <= hi) ATT_LOAD(ka, va, lo);
    if (lo + 1 <= hi) ATT_LOAD(kb, vb, lo + 1);
    for (int kt = lo; kt <= hi; kt += 2) {
        ATT_STEP(ka, va, kt);
        if (kt + 1 <= hi) ATT_STEP(kb, vb, kt + 1);
    }
#undef ATT_LOAD
#undef ATT_STEP
    l += __shfl_xor(l, 32);
    m_out = m; l_out = l;
}
__device__ __forceinline__ void attn_store(const f32x16 (&o)[2], float scale, bf16_t* rowp, int h) {
#pragma unroll
    for (int dt = 0; dt < 2; ++dt)
#pragma unroll
        for (int g = 0; g < 4; ++g) { u32x2 w; w.x = pk_bf16(o[dt][4 * g] * scale, o[dt][4 * g + 1] * scale); w.y = pk_bf16(o[dt][4 * g + 2] * scale, o[dt][4 * g + 3] * scale);
            *(u32x2*)(rowp + 32 * dt + 8 * g + 4 * h) = w; }
}

constexpr int N_ITEMS_A = 3 * 8 * 12 * 64, N_ITEMS_B = 8 * 10 * 64, N_ITEMS_C = 8 * 10 * 16 * 4;

__device__ __forceinline__ void attn_phase(LAS unsigned char* lds, const bf16_t* proj, bf16_t* Ao, float* Al, bf16_t* mixed, const float* sink, const float* rpb, int gw, int ngw, int wave, int lane) {
    LAS unsigned char* wl = lds + wave * WAVE_LDS;
    const int r = lane & 31, h = lane >> 5;
    for (int it = gw; it < N_ITEMS_B + N_ITEMS_C; it += ngw) {
        if (it < N_ITEMS_B) {
            const int bh = it >> 6, qb = ((it & 63) + 13 * (bh >> 5)) & 63, b = bh / 10, hq = bh % 10, kvh = hq / 5;
            PolB P; P.tokbase = b * T; P.q0 = 32 * qb;
            float m, l; f32x16 o[2];
            attn_run<PolB, false>(P, wl, proj, 2304 + hq * 64, 2944 + kvh * 64, 3072 + kvh * 64, lane, m, l, o);
            const float den = l + __builtin_amdgcn_exp2f(sink[hq] * LOG2E - m);
            attn_store(o, 1.0f / den, mixed + (size_t)P.q_tok(r) * D + 768 + hq * 64, h);
        } else {
            const int ic = it - N_ITEMS_B, cb = ic & 3, Rp = (ic >> 2) & 15, bh = ic >> 6, b = bh / 10, hd = bh % 10;
            LAS float* tab = (LAS float*)(wl + 9216);
            for (int i = lane; i < 465; i += 64) tab[i] = rpb[hd * 465 + i] * LOG2E;
            PolC P; P.tokbase = b * T; P.Rp = Rp; P.cb = cb; { int s = 2 * Rp - 4; P.rs0 = s < 0 ? 0 : (s > 24 ? 24 : s); } { int s1 = 2 * Rp + 1 - 4; s1 = s1 < 0 ? 0 : (s1 > 24 ? 24 : s1); P.nt = s1 + 8 - P.rs0; } { int s = 16 * cb - 8; P.kc0 = s < 0 ? 0 : (s > 32 ? 32 : s); }
            P.Rq = 2 * Rp + (r >> 4); P.c = 16 * cb + (r & 15); { int s = P.Rq - 4; P.rsq = s < 0 ? 0 : (s > 24 ? 24 : s); } { int s = P.c - 8; P.csq = s < 0 ? 0 : (s > 48 ? 48 : s); }
            P.tab = tab;
            float m, l; f32x16 o[2];
            attn_run<PolC, true>(P, wl, proj, 3200 + hd * 64, 3840 + hd * 64, 4480 + hd * 64, lane, m, l, o);
            attn_store(o, 1.0f / l, mixed + (size_t)P.q_tok(r) * D + 1408 + hd * 64, h);
        }
    }
    for (int it = gw; it < N_ITEMS_A; it += ngw) {
        const int c = it / 6144, rem = it % 6144, bh = rem >> 6, b = bh / 12, hd = bh % 12;
        const int w = ((rem & 63) + 11 * (bh >> 5) + 23 * c) & 63;
        const int rr = (c == 0) ? 1 : (c == 1 ? 4 : 16), nblk = 64 / rr;
        PolA P; P.tokbase = b * T; P.r = rr; P.rho = w / nblk; P.jb = 32 * (w % nblk); P.L = T / rr;
        float m, l; f32x16 o[2];
        attn_run<PolA, false>(P, wl, proj, hd * 64, 768 + hd * 64, 1536 + hd * 64, lane, m, l, o);
        const int tok = P.q_tok(r);
        attn_store(o, 1.0f / l, Ao + ((size_t)c * M + tok) * 768 + hd * 64, h);
        if (h == 0) Al[((size_t)c * M + tok) * 12 + hd] = m + __builtin_amdgcn_logf(l);
    }
}

__device__ __forceinline__ void mixnorm_phase(const bf16_t* Ao, const float* Al, bf16_t* mixed, int gw, int ngw, int lane) {
    for (int t = gw; t < M; t += ngw) {
        bf16_t* mrow = mixed + (size_t)t * D;
        u32x2 ab[3][3]; float ls[3][3]; u32x2 gb[2][3];
#pragma unroll
        for (int j = 0; j < 3; ++j) { const int c4 = (j * 64 + lane) * 4, hd = c4 >> 6;
#pragma unroll
            for (int c = 0; c < 3; ++c) { ab[c][j] = *(const u32x2*)(Ao + ((size_t)c * M + t) * 768 + c4); ls[c][j] = Al[((size_t)c * M + t) * 12 + hd]; } }
#pragma unroll
        for (int grp = 0; grp < 2; ++grp)
#pragma unroll
            for (int j = 0; j < 3; ++j) { const int ch = j * 64 + lane; gb[grp][j] = (u32x2){0u, 0u}; if (ch < 160) gb[grp][j] = *(const u32x2*)(mrow + 768 + 640 * grp + ch * 4); }
        asm volatile("" ::: "memory");
        float va[3][4]; float sa = 0.f;
#pragma unroll
        for (int j = 0; j < 3; ++j) {
            const float l0 = ls[0][j], l1 = ls[1][j], l2 = ls[2][j];
            const float mx = fmaxf(l0, fmaxf(l1, l2)); float w0 = __builtin_amdgcn_exp2f(l0 - mx), w1 = __builtin_amdgcn_exp2f(l1 - mx), w2 = __builtin_amdgcn_exp2f(l2 - mx);
            const float inv = 1.0f / (w0 + w1 + w2); w0 *= inv; w1 *= inv; w2 *= inv;
            const u32x2 a0 = ab[0][j], a1 = ab[1][j], a2 = ab[2][j];
            va[j][0] = w0 * bflo(a0.x) + w1 * bflo(a1.x) + w2 * bflo(a2.x); va[j][1] = w0 * bfhi(a0.x) + w1 * bfhi(a1.x) + w2 * bfhi(a2.x);
            va[j][2] = w0 * bflo(a0.y) + w1 * bflo(a1.y) + w2 * bflo(a2.y); va[j][3] = w0 * bfhi(a0.y) + w1 * bfhi(a1.y) + w2 * bfhi(a2.y);
            sa += (va[j][0] * va[j][0] + va[j][1] * va[j][1]) + (va[j][2] * va[j][2] + va[j][3] * va[j][3]); }
        float v[2][3][4]; float sg[2] = {0.f, 0.f};
#pragma unroll
        for (int grp = 0; grp < 2; ++grp)
#pragma unroll
            for (int j = 0; j < 3; ++j) { const u32x2 a = gb[grp][j]; v[grp][j][0] = bflo(a.x); v[grp][j][1] = bfhi(a.x); v[grp][j][2] = bflo(a.y); v[grp][j][3] = bfhi(a.y);
                sg[grp] += (v[grp][j][0] * v[grp][j][0] + v[grp][j][1] * v[grp][j][1]) + (v[grp][j][2] * v[grp][j][2] + v[grp][j][3] * v[grp][j][3]); }
        const float rsa = __builtin_amdgcn_rsqf(wave_sum(sa) * (1.0f / 768.0f) + EPS);
        const float rsg0 = __builtin_amdgcn_rsqf(wave_sum(sg[0]) * (1.0f / 640.0f) + EPS), rsg1 = __builtin_amdgcn_rsqf(wave_sum(sg[1]) * (1.0f / 640.0f) + EPS);
#pragma unroll
        for (int j = 0; j < 3; ++j) { u32x2 w; w.x = pk_bf16(va[j][0] * rsa, va[j][1] * rsa); w.y = pk_bf16(va[j][2] * rsa, va[j][3] * rsa); *(u32x2*)(mrow + (j * 64 + lane) * 4) = w; }
#pragma unroll
        for (int grp = 0; grp < 2; ++grp) { const float rsg = grp ? rsg1 : rsg0;
#pragma unroll
            for (int j = 0; j < 3; ++j) { const int ch = j * 64 + lane; if (ch < 160) { u32x2 w; w.x = pk_bf16(v[grp][j][0] * rsg, v[grp][j][1] * rsg); w.y = pk_bf16(v[grp][j][2] * rsg, v[grp][j][3] * rsg); *(u32x2*)(mrow + 768 + 640 * grp + ch * 4) = w; } } }
    }
}
typedef GAS unsigned gu32;
typedef GAS unsigned long long gu64;
#define RLX_AGENT __ATOMIC_RELAXED, __HIP_MEMORY_SCOPE_AGENT
#define XB_TMO      128
#define XB_XCNT(j)  (256  + 64 * (j))
#define XB_XSUB(j)  (1280 + 64 * (j))
#define XB_XGEN(j)  (2304 + 64 * (j))
#define XB_TOP      3328
#define XB_TOPGEN   3392
#define XCD_BAR_WORDS 3456
#define XB_SPIN_CAP (1u << 18)

__device__ __forceinline__ unsigned xb_ld(unsigned* p)              { return __hip_atomic_load(p, __ATOMIC_RELAXED, __HIP_MEMORY_SCOPE_AGENT); }
__device__ __forceinline__ unsigned xb_add(unsigned* p, unsigned v) { return __hip_atomic_fetch_add(p, v, __ATOMIC_RELAXED, __HIP_MEMORY_SCOPE_AGENT); }
__device__ __forceinline__ unsigned xb_xcc_id() { return (unsigned)__builtin_amdgcn_s_getreg((3 << 11) | 20) & 0xFu; }
#define XB_SPIN(cond, bar) do { unsigned _sp = 0; while (cond) { __builtin_amdgcn_s_sleep(1); \
    if ((++_sp & 255u) == 0u) { if (xb_ld(&(bar)[XB_TMO])) break; if (_sp > XB_SPIN_CAP) { atomicAdd(&(bar)[XB_TMO], 1u); break; } } } } while (0)

struct XcdBarrier {
    unsigned* bar; unsigned x;
    volatile LAS unsigned* st;
};

__device__ __forceinline__ XcdBarrier xcd_barrier_post(unsigned* bar, volatile LAS unsigned* st) {
    XcdBarrier b; b.bar = bar; b.x = xb_xcc_id(); b.st = st;
    if (threadIdx.x == 0) (void)xb_add(&bar[XB_XCNT(b.x)], 1u);
    return b;
}
__device__ __forceinline__ void xcd_barrier_complete(unsigned* bar, unsigned x, unsigned& nloc, unsigned& nx) {
    const unsigned G = gridDim.x * gridDim.y * gridDim.z;
    unsigned sum, cnt, mine, sp = 0u;
    for (;;) {
        sum = 0u; cnt = 0u; mine = 0u;
#pragma unroll
        for (unsigned j = 0; j < 16; ++j) { const unsigned c = xb_ld(&bar[XB_XCNT(j)]); sum += c; cnt += (c > 0u) ? 1u : 0u; mine = (j == x) ? c : mine; }
        if (sum == G) break;
        __builtin_amdgcn_s_sleep(1);
        if ((++sp & 255u) == 0u) { if (xb_ld(&bar[XB_TMO])) break; if (sp > XB_SPIN_CAP) { atomicAdd(&bar[XB_TMO], 1u); break; } }
    }
    nloc = mine > 0u ? mine : 1u; nx = cnt > 0u ? cnt : 1u;
}

__device__ __forceinline__ void xcd_barrier(const XcdBarrier& b) {
    asm volatile("s_waitcnt vmcnt(0)" ::: "memory");
    __syncthreads();
    if (threadIdx.x == 0) {
        unsigned* bar = b.bar;
        __builtin_amdgcn_s_waitcnt(0);
        unsigned nloc = b.st[0], nx = b.st[1];
        if (nloc == 0u) { xcd_barrier_complete(bar, b.x, nloc, nx); b.st[0] = nloc; b.st[1] = nx; }
        const unsigned old = xb_add(&bar[XB_XSUB(b.x)], 1u);
        const unsigned gen = old / nloc;
        if (old + 1u == (gen + 1u) * nloc) {
            __builtin_amdgcn_fence(__ATOMIC_RELEASE, "agent");
            asm volatile("s_waitcnt vmcnt(0)" ::: "memory");
            const unsigned og = xb_add(&bar[XB_TOP], 1u);
            const unsigned tg = og / nx;
            if (og + 1u == (tg + 1u) * nx) xb_add(&bar[XB_TOPGEN], 1u);
            else XB_SPIN(xb_ld(&bar[XB_TOPGEN]) == tg, bar);
            __builtin_amdgcn_fence(__ATOMIC_ACQUIRE, "agent");
            xb_add(&bar[XB_XGEN(b.x)], 1u);
            asm volatile("s_waitcnt vmcnt(0)" ::: "memory");
        } else {
            XB_SPIN(xb_ld(&bar[XB_XGEN(b.x)]) == gen, bar);
            __builtin_amdgcn_fence(__ATOMIC_ACQUIRE, "agent");
            asm volatile("s_waitcnt vmcnt(0)" ::: "memory");
        }
    }
    __syncthreads();
}

struct Args { const float* in[13]; float* out; unsigned char* ws; };
__global__ void __launch_bounds__(NTHREADS, 2) fwd_kernel(Args a) {
    extern __shared__ __attribute__((aligned(16))) unsigned char lds_raw[];
    cg::grid_group grid = cg::this_grid();
    LAS unsigned char* lds = (LAS unsigned char*)lds_raw;
    const int tid = threadIdx.x, lane = tid & 63, wave = __builtin_amdgcn_readfirstlane(tid >> 6);
    const int G = gridDim.x, gw = blockIdx.x * NWAVES + wave, ngw = G * NWAVES, gt = blockIdx.x * NTHREADS + tid, ngt = G * NTHREADS;
#define GSYNC() do { XcdBarrier xb_; xb_.bar = (unsigned*)WSP(WS_BAR); xb_.x = xb_xcc_id(); xb_.st = (volatile LAS unsigned*)(lds + 131072 + 512); xcd_barrier(xb_); } while (0)
    LAS unsigned* PT = (LAS unsigned*)(lds + 131072 + 256);
    if (tid < 15) { const unsigned long long v = (tid < 13) ? (unsigned long long)a.in[tid] : (tid == 13 ? (unsigned long long)a.out : (unsigned long long)a.ws); PT[2 * tid] = (unsigned)v; PT[2 * tid + 1] = (unsigned)(v >> 32); }
    if (tid < 2) ((LAS unsigned*)(lds + 131072 + 512))[tid] = 0u;
    __syncthreads();
#define GPTR(i) ({ unsigned ptb_ = 131072 + 256; asm volatile("" : "+v"(ptb_));   \
    volatile LAS unsigned* ptp_ = (volatile LAS unsigned*)(lds + ptb_); \
    (GAS unsigned char*)(((unsigned long long)(unsigned)__builtin_amdgcn_readfirstlane(ptp_[2 * (i) + 1]) << 32) | (unsigned)__builtin_amdgcn_readfirstlane(ptp_[2 * (i)])); })
#define INF(i) ((const float*)GPTR(i))
#define OUTP ((float*)GPTR(13))
#define WSP(off) ((unsigned char*)GPTR(14) + (off))
#define x_in INF(0)
#define sink_b INF(3)
#define rpb_c INF(4)
#define conv_w INF(9)
#define conv_b INF(10)
#define ln_final INF(12)
#define out OUTP
#define SS ((float*)WSP(WS_SSP))
#define AL ((float*)WSP(WS_AL))
#define XB ((bf16_t*)WSP(WS_XB))
#define PROJ ((bf16_t*)WSP(WS_PROJ))
#define AO ((bf16_t*)WSP(WS_AO))
#define MIX ((bf16_t*)WSP(WS_MIX))
#define EPART ((float*)WSP(WS_EPART))
#define ERAW ((float*)WSP(WS_ERAW))
#define CWT ((float*)WSP(WS_CW))
#define GB ((bf16_t*)WSP(WS_G))
    {
        LAS unsigned* scr = (LAS unsigned*)(lds + wave * 16384);
        constexpr int I_IN = (D / 64) * (NIN / 64), I_OUT = (D / 64) * (D / 64), I_UP = (D / 64) * (NUP / 64), I_DN = (DFF / 64) * (D / 64);
        for (int it = gw; it < I_IN; it += ngw) transpose_item<1>(INF(2), D, NIN, (bf16_t*)WSP(WS_WIN), INF(1), scr, it, lane);
        const float* xin_ = x_in; bf16_t* xb_ = XB; float* ss_ = SS;
        for (int m = gw; m < M; m += ngw) {
            const f32x4* xr = (const f32x4*)(xin_ + (size_t)m * D) + lane; float s = 0.f; u32x2* o8 = (u32x2*)(xb_ + (size_t)m * D) + lane; f32x4 xv[8];
#pragma unroll
            for (int j = 0; j < 8; ++j) xv[j] = __builtin_nontemporal_load(xr + 64 * j);
#pragma unroll
            for (int j = 0; j < 8; ++j) { const f32x4 v = xv[j]; s += (v[0] * v[0] + v[1] * v[1]) + (v[2] * v[2] + v[3] * v[3]); u32x2 w; w.x = pk_bf16(v[0], v[1]); w.y = pk_bf16(v[2], v[3]); o8[64 * j] = w; }
            s = wave_sum(s); if (lane < 8) ss_[(size_t)m * 8 + lane] = (lane == 0) ? s : 0.f;
        }
        { float* cwt = CWT; const float* cwi = conv_w; const float* cbi = conv_b;
          for (int i = gt; i < 2 * 4 * NUP; i += ngt) { const int l = i / (4 * NUP), k = (i / NUP) & 3, np = i % NUP, pn = np >> 8, bj = (np >> 7) & 1, j = np & 127, src = bj * DFF + pn * 128 + j;
            cwt[i] = (k < 3) ? cwi[((size_t)l * 3 + k) * NUP + src] : cbi[(size_t)l * NUP + src]; } }
        if (blockIdx.x == 0) { unsigned* bw = (unsigned*)WSP(WS_BAR); for (int i = tid; i < XCD_BAR_WORDS; i += NTHREADS) bw[i] = 0u; }
    }
    grid.sync();
    (void)xcd_barrier_post((unsigned*)WSP(WS_BAR), (volatile LAS unsigned*)(lds + 131072 + 512));

#define CONVERT_SET(FIRST_L, WITH_IN) do { const int j_ = bid_ >> 3; \
        if (G_ != 256 || (j_ & 1)) { LAS unsigned* scr = (LAS unsigned*)(lds + wave_ * 16384); const int ow = (G_ == 256) ? ((bid_ & 7) * 16 + (j_ >> 1)) * NWAVES + wave_ : gw_, now = (G_ == 256) ? 128 * NWAVES : ngw_;     \
            constexpr int I_IN = (D / 64) * (NIN / 64), I_OUT = (D / 64) * (D / 64), I_UP = (D / 64) * (NUP / 64), I_DN = (DFF / 64) * (D / 64); \
            const int l_ = (FIRST_L); const int tot = ((WITH_IN) ? I_IN : 0) + I_OUT + I_UP + I_DN; \
            for (int it = ow; it < tot; it += now) { int r = it; \
                if (WITH_IN) { if (r < I_IN) { transpose_item<1>(INF(2) + (size_t)l_ * D * NIN, D, NIN, (bf16_t*)WSP(WS_WIN) + (size_t)l_ * NIN * D, INF(1) + l_ * D, scr, r, lane_); continue; } r -= I_IN; } \
                if (r < I_OUT) { transpose_item<0>(INF(6) + (size_t)l_ * D * D, D, D, (bf16_t*)WSP(WS_WOUT) + (size_t)l_ * D * D, INF(5) + l_ * D, scr, r, lane_); continue; } r -= I_OUT; \
                if (r < I_UP) { transpose_item<2>(INF(8) + (size_t)l_ * D * NUP, D, NUP, (bf16_t*)WSP(WS_WUP) + (size_t)l_ * NUP * D, INF(7) + l_ * D, scr, r, lane_); continue; } r -= I_UP; \
                transpose_item<0, false>(INF(11) + (size_t)l_ * DFF * D, DFF, D, (bf16_t*)WSP(WS_WDOWN) + (size_t)l_ * D * DFF, nullptr, scr, r, lane_); } \
            __syncthreads(); } } while (0)
#pragma nounroll
    for (int l = 0; l < 2; ++l) {
#define OPQ() int tid_ = threadIdx.x, G_ = gridDim.x, bid_ = blockIdx.x; asm volatile("" : "+v"(tid_), "+s"(G_), "+s"(bid_)); const int lane_ = tid_ & 63, wave_ = __builtin_amdgcn_readfirstlane(tid_ >> 6), gw_ = bid_ * NWAVES + wave_, ngw_ = G_ * NWAVES, gt_ = bid_ * NTHREADS + tid_, ngt_ = G_ * NTHREADS; (void)lane_; (void)gw_; (void)ngw_; (void)gt_; (void)ngt_
        { OPQ(); pg8::Gemm g{XB, (bf16_t*)WSP(WS_WIN) + (size_t)l * NIN * D, M, NIN, D}; pg8::StaticOrder S; S.init(M, NIN, G_, bid_, l == 0);
          pg8::EpiInProj E{PROJ, SS + (size_t)(2 * l) * M * 8, (LAS float*)(lds + 147456), (LAS float*)(lds + 131072 + 15360)};
          pg8::gemm_phase<pg8::EpiInProj, pg8::StaticOrder, true, true>(lds, g, S, E);
          if (l == 0) { __syncthreads(); CONVERT_SET(0, false); } }
        GSYNC();
        { OPQ(); attn_phase(lds, PROJ, AO, AL, MIX, sink_b + l * 10, rpb_c + l * 10 * 465, gw_, ngw_, wave_, lane_); }
        GSYNC();
        { OPQ(); mixnorm_phase(AO, AL, MIX, gw_, ngw_, lane_); }
        GSYNC();
        { OPQ(); pg8::Gemm g{MIX, (bf16_t*)WSP(WS_WOUT) + (size_t)l * D * D, M, D, D}; pg8::StaticOrder S; S.init(M, D, G_, bid_);
          pg8::EpiResid E{XB, SS + (size_t)(2 * l + 1) * M * 8, (LAS float*)(lds + 131072 + 1024)};
          pg8::gemm_phase<pg8::EpiResid, pg8::StaticOrder, true, true>(lds, g, S, E); }
        GSYNC();
        { OPQ(); pg8::Gemm g{XB, (bf16_t*)WSP(WS_WUP) + (size_t)l * NUP * D, M, NUP, D}; pg8::StaticOrder S; S.init(M, NUP, G_, bid_, l == 0);
          pg8::EpiUpConv E{GB, SS + (size_t)(2 * l + 1) * M * 8, CWT + (size_t)l * 4 * NUP, EPART, ERAW, (LAS float*)(lds + 131072 + 1024), (LAS float*)(lds + 131072 + 15360), (LAS float*)(lds + 147456), (LAS float*)(lds + 131072 + 7168)};
          pg8::gemm_phase<pg8::EpiUpConv, pg8::StaticOrder, true, true>(lds, g, S, E);
          if (l == 0) { __syncthreads(); CONVERT_SET(1, true); } }
        GSYNC();
        { OPQ(); const float* ep = EPART; const float* er = ERAW; const float* cwl = CWT + (size_t)l * 4 * NUP; bf16_t* gb = GB;
          for (int i = gt_; i < 128 * (DFF / 4); i += ngt_) { const int rr = i / (DFF / 4), j4 = (i % (DFF / 4)) * 4, pm = rr >> 1, which = rr & 1, np = 256 * (j4 >> 7) + (j4 & 127);
            const bool has = which ? ((pm & 7) != 7) : ((pm & 7) != 0); const int pmn = which ? pm + 1 : pm - 1;
            f32x4 uu[2];
#pragma unroll
            for (int bj = 0; bj < 2; ++bj) { const size_t o = (size_t)(pm * 2 + which) * NUP + np + 128 * bj; f32x4 v = *(const f32x4*)(ep + o);
                if (has) { const f32x4 nb = *(const f32x4*)(er + (size_t)(pmn * 2 + (1 - which)) * NUP + np + 128 * bj), w = *(const f32x4*)(cwl + (size_t)(which ? 2 : 0) * NUP + np + 128 * bj); v = v + w * nb; }
                uu[bj] = v; }
            float gg[4];
#pragma unroll
            for (int e = 0; e < 4; ++e) { const float xg = uu[0][e]; gg[e] = xg * __builtin_amdgcn_rcpf(1.0f + __builtin_amdgcn_exp2f(-LOG2E * xg)) * uu[1][e]; }
            u32x2 w; w.x = pk_bf16(gg[0], gg[1]); w.y = pk_bf16(gg[2], gg[3]);
            *(u32x2*)(gb + (size_t)(pm * 256 + (which ? 255 : 0)) * DFF + j4) = w; } }
        GSYNC();
        { OPQ(); pg8::Gemm g{GB, (bf16_t*)WSP(WS_WDOWN) + (size_t)l * D * DFF, M, D, DFF}; pg8::StaticOrder S; S.init(M, D, G_, bid_);
          pg8::EpiResid E{XB, SS + (size_t)(2 * l + 2) * M * 8, (LAS float*)(lds + 131072 + 1024)};
          pg8::gemm_phase<pg8::EpiResid, pg8::StaticOrder, true, true>(lds, g, S, E); }
        GSYNC();
    }
    OPQ(); float* fo_ = out; const float* fss_ = SS; const float* fg_ = ln_final; const bf16_t* fx_ = XB;
    for (int m = gw_; m < M; m += ngw_) { const int lane = lane_;
        float sp = (lane < 8) ? fss_[((size_t)4 * M + m) * 8 + lane] : 0.f; sp = wave_sum(sp);
        const float rs = __builtin_amdgcn_rsqf(sp * (1.0f / 2048.0f) + EPS);
        f32x4* xr = (f32x4*)(fo_ + (size_t)m * D) + lane; const f32x4* gr = (const f32x4*)fg_ + lane; const u32x2* br = (const u32x2*)(fx_ + (size_t)m * D) + lane; u32x2 bq[8]; f32x4 gq[8];
#pragma unroll
        for (int j = 0; j < 8; ++j) { bq[j] = br[64 * j]; gq[j] = gr[64 * j]; }
#pragma unroll
        for (int j = 0; j < 8; ++j) { const u32x2 b = bq[j]; const f32x4 v = {bflo(b.x), bfhi(b.x), bflo(b.y), bfhi(b.y)}; xr[64 * j] = v * rs * gq[j]; }
    }
}
#undef out
#undef x_in
#undef SS
extern "C" void kernel_launch(void* const* d_in, const int* in_sizes, int n_in, void* d_out, int out_size, void* d_ws, size_t ws_size, hipStream_t stream) {
    static int grid = 0;
    if (grid == 0) {
        if (n_in != 13 || out_size != M * D || ws_size < WS_END) { fprintf(stderr, "kernel_launch: unexpected shapes (n_in %d out %d ws %zu)\n", n_in, out_size, ws_size); grid = -1; return; }
        int dev = 0, cus = 0, per = 0;
        (void)hipGetDevice(&dev);
        (void)hipDeviceGetAttribute(&cus, hipDeviceAttributeMultiprocessorCount, dev);
        (void)hipFuncSetAttribute((const void*)fwd_kernel, hipFuncAttributeMaxDynamicSharedMemorySize, LDS_BYTES);
        (void)hipOccupancyMaxActiveBlocksPerMultiprocessor(&per, (const void*)fwd_kernel, NTHREADS, LDS_BYTES);
        if (per < 1) per = 1;
        grid = cus * per;
    }
    if (grid < 0) return;
    Args a{};
    for (int i = 0; i < 13; ++i) a.in[i] = (const float*)d_in[i];
    a.out = (float*)d_out; a.ws = (unsigned char*)d_ws;
    void* args[] = {&a};
    hipError_t e = hipLaunchCooperativeKernel((void*)fwd_kernel, dim3(grid), dim3(NTHREADS), args, LDS_BYTES, stream);
    if (e != hipSuccess) fprintf(stderr, "cooperative launch failed: %s (grid %d)\n", hipGetErrorString(e), grid);
}
```

```cpp
#include <hip/hip_runtime.h>
#include <hip/hip_cooperative_groups.h>
#include <cstdio>
#include <cstdint>
namespace cg = cooperative_groups;
namespace pg8 {
#define PG8_LAS __attribute__((address_space(3)))
typedef unsigned short bf16_t;
typedef short bf16x8 __attribute__((ext_vector_type(8)));
typedef float f32x4 __attribute__((ext_vector_type(4)));
typedef unsigned u32x4 __attribute__((ext_vector_type(4)));
constexpr int BM = 256, BK = 64, HALF = 128, HTB = HALF * BK * 2  , STAGE_BYTES = 8 * HTB, NXCD = 8, WGM = 8;

__host__ __device__ __forceinline__ int lds_byte(int r, int c) { const int st = (r >> 4) * 2 + (c >> 5), rr = r & 15, cc = c & 31, ob = rr * 64 + cc * 2; return st * 1024 + (ob ^ (((ob >> 9) & 1) << 5)); }
__host__ __device__ __forceinline__ void stage_rc(int b, int& R, int& C) { const int st = b / 1024, sb = b % 1024, swz = sb ^ (((sb >> 9) & 1) << 5); R = (st >> 1) * 16 + swz / 64; C = (st & 1) * 32 + (swz % 64) / 2; }
__host__ __device__ __forceinline__ int perm32(int rho) { const int n = rho >> 4, i = rho & 15; return 8 * (i >> 2) + 4 * n + (i & 3); }

struct Unit { int pm, pn; };
struct Gemm { const bf16_t* A; const bf16_t* Bt; int M, N, K; };

struct StaticOrder {
    int nM, nN, nwg, G, c; bool uneven;
    __host__ __device__ void init(int M, int N, int G_, int c_, bool uneven_ = false) { nM = M / BM; nN = N / BM; nwg = nM * nN; G = G_; c = c_; uneven = uneven_ && (G_ == 256); }
    __host__ __device__ bool next(int i, Unit& u) const {
        int wgid;
        if (uneven) { const int q = nwg / NXCD, xcd = c % NXCD, j = c / NXCD, RF = nwg / 256 - 1; int off;
            if (i < RF) off = i * 32 + j; else { if ((j & 1) || i >= RF + 2) return false; off = RF * 32 + (i - RF) * 16 + (j >> 1); }
            wgid = xcd * q + off;
        } else {
            const long L = (long)i * G + c; if (L >= nwg) return false;
            wgid = (int)L; { const int q = nwg / NXCD, r = nwg % NXCD, xcd = wgid % NXCD, off = wgid / NXCD; wgid = (xcd < r ? xcd * (q + 1) : r * (q + 1) + (xcd - r) * q) + off; }
        }
        const int nig = WGM * nN, gid = wgid / nig, fm = gid * WGM, gsz = (nM - fm) < WGM ? (nM - fm) : WGM;
        u.pm = fm + ((wgid % nig) % gsz); u.pn = (wgid % nig) / gsz; return true;
    }
    __device__ __forceinline__ void a_ready(const Unit&) const {}
    __device__ __forceinline__ void done(const Unit&) const {}
};

__device__ __forceinline__ unsigned cvt_pk_bf16(float lo, float hi) { unsigned r; asm volatile("v_cvt_pk_bf16_f32 %0, %1, %2" : "=v"(r) : "v"(lo), "v"(hi)); return r; }
typedef float f32x2 __attribute__((ext_vector_type(2)));
typedef unsigned u32x2 __attribute__((ext_vector_type(2)));
typedef __bf16 bf16x2_t __attribute__((ext_vector_type(2)));
__device__ __forceinline__ unsigned pk_bf16(float lo, float hi) { f32x2 v = {lo, hi}; bf16x2_t b = __builtin_convertvector(v, bf16x2_t); return __builtin_bit_cast(unsigned, b); }
constexpr float RMS_EPS = 1e-6f;

#define LAS3 __attribute__((address_space(3)))
__device__ __forceinline__ void ssp_prefetch(const float* ssp, int pm, LAS3 float* sspl, int wid, int lane) {
    const float* gp = ssp + ((size_t)(pm * BM + 32 * wid + (lane >> 1)) * 8 + (lane & 1) * 4);
    __builtin_amdgcn_global_load_lds((const unsigned*)gp, (LAS3 unsigned*)(sspl + wid * 256), 16, 0, 0);
}
__device__ __forceinline__ void rs_table_from_lds(const LAS3 float* sspl, LAS3 float* rsl, int tid) {
    const int r = tid >> 1, hf = tid & 1; const f32x4 a = *(const LAS3 f32x4*)(sspl + r * 8 + hf * 4);
    float sum = (a[0] + a[1]) + (a[2] + a[3]); sum += __shfl_xor(sum, 1);
    if (hf == 0) rsl[r] = __builtin_amdgcn_rsqf(sum * (1.0f / 2048.0f) + RMS_EPS);
}
#define PG8_LDS_BAR() do { asm volatile("s_waitcnt lgkmcnt(0)" ::: "memory"); __builtin_amdgcn_s_barrier(); asm volatile("" ::: "memory"); } while (0)

struct EpiInProj {
    static constexpr bool PERM = true, AFTER_DRAIN = false;
    bf16_t* O; const float* ssp; LAS3 float* sspl0; LAS3 float* rsl;
    __device__ __forceinline__ void prefetch(const Unit& u, int par, int wid, int lane) const { ssp_prefetch(ssp, u.pm, sspl0 + par * 2048, wid, lane); }
    __device__ __forceinline__ void operator()(const f32x4 (&acc)[2][2][4][2], const Unit& u, int wr, int wc, int fr, int fq, int par) const {
        const LAS3 float* sspl = sspl0 + par * 2048;
        const int row0 = u.pm * BM + wr * 64 + fr, col0 = u.pn * BM + wc * 32 + 8 * fq;
        const bool rot = (u.pn < 6) || (u.pn >= 9 && u.pn < 12);
        rs_table_from_lds(sspl, rsl, (wr * 4 + wc) * 64 + fq * 16 + fr); PG8_LDS_BAR();
        float rs[2][4];
#pragma unroll
        for (int ai = 0; ai < 2; ++ai)
#pragma unroll
            for (int m = 0; m < 4; ++m) rs[ai][m] = rsl[wr * 64 + fr + ai * HALF + m * 16];
        float sc[2];
#pragma unroll
        for (int bj = 0; bj < 2; ++bj) { const int cb = u.pn * BM + bj * HALF; const bool isq = (cb < 768) || (cb >= 2304 && cb < 2944) || (cb >= 3200 && cb < 3840); sc[bj] = isq ? 0.125f * 1.4426950408889634f : 1.0f; }
        float frev[2][2];
#pragma unroll
        for (int n = 0; n < 2; ++n)
#pragma unroll
            for (int p = 0; p < 2; ++p) { const int i = 16 * (wc & 1) + 4 * fq + 2 * n + p; frev[n][p] = __builtin_amdgcn_exp2f(-(float)i * (13.287712379549449f / 32.0f)) * 0.15915494309189535f; }
#pragma unroll
        for (int ai = 0; ai < 2; ++ai)
#pragma unroll
            for (int m = 0; m < 4; ++m) { const int row = row0 + ai * HALF + m * 16; const float rsv = rs[ai][m];
                bf16_t* rowp = O + (size_t)row * 5120 + col0; const float tpos = (float)(row & 2047);
                f32x4 r4[2] = {{1.f, 0.f, 1.f, 0.f}, {1.f, 0.f, 1.f, 0.f}};
                if (rot) {
#pragma unroll
                    for (int n = 0; n < 2; ++n)
#pragma unroll
                        for (int p = 0; p < 2; ++p) { const float rev = __builtin_amdgcn_fractf(tpos * frev[n][p]); r4[n][2 * p] = __builtin_amdgcn_cosf(rev); r4[n][2 * p + 1] = __builtin_amdgcn_sinf(rev); } }
#pragma unroll
                for (int bj = 0; bj < 2; ++bj) { f32x4 v[2]; const float s2 = rsv * sc[bj];
#pragma unroll
                    for (int n = 0; n < 2; ++n) { const f32x4 a = acc[ai][bj][m][n] * s2; const f32x4 c = r4[n];
                        f32x4 o; o[0] = a[0] * c[0] - a[1] * c[1]; o[1] = a[1] * c[0] + a[0] * c[1]; o[2] = a[2] * c[2] - a[3] * c[3]; o[3] = a[3] * c[2] + a[2] * c[3];
                        v[n] = o; }
                    u32x4 w; w.x = pk_bf16(v[0][0], v[0][1]); w.y = pk_bf16(v[0][2], v[0][3]); w.z = pk_bf16(v[1][0], v[1][1]); w.w = pk_bf16(v[1][2], v[1][3]);
                    *(u32x4*)(rowp + bj * HALF) = w; } }
    }
};
struct EpiResid {
    static constexpr bool PERM = true, AFTER_DRAIN = false;
    bf16_t* xb; float* ss; LAS3 float* part  ;
    __device__ __forceinline__ void prefetch(const Unit&, int, int, int) const {}
    __device__ __forceinline__ void operator()(const f32x4 (&acc)[2][2][4][2], const Unit& u, int wr, int wc, int fr, int fq, int) const {
        const int row0 = u.pm * BM + wr * 64 + fr, col0 = u.pn * BM + wc * 32 + 8 * fq;
        u32x4 bq[2][2][2];
#define RES_LOAD(q_, slot_) do { _Pragma("unroll") for (int mm = 0; mm < 2; ++mm) _Pragma("unroll") for (int bj = 0; bj < 2; ++bj) \
            bq[slot_][mm][bj] = *(const u32x4*)(xb + (size_t)(row0 + ((q_) >> 1) * HALF + (2 * ((q_) & 1) + mm) * 16) * 2048 + col0 + bj * HALF); } while (0)
        RES_LOAD(0, 0);
#pragma unroll
        for (int q = 0; q < 4; ++q) { const int ai = q >> 1, slot = q & 1;
            if (q + 1 < 4) RES_LOAD(q + 1, (q + 1) & 1);
#pragma unroll
            for (int mm = 0; mm < 2; ++mm) { const int m = 2 * (q & 1) + mm, row = row0 + ai * HALF + m * 16; bf16_t* rowp = xb + (size_t)row * 2048 + col0; float sq = 0.f;
#pragma unroll
                for (int bj = 0; bj < 2; ++bj) { const u32x4 b = bq[slot][mm][bj]; const f32x4 a0 = acc[ai][bj][m][0], a1 = acc[ai][bj][m][1];
                    float o[8];
                    o[0] = __uint_as_float(b.x << 16) + a0[0]; o[1] = __uint_as_float(b.x & 0xffff0000u) + a0[1]; o[2] = __uint_as_float(b.y << 16) + a0[2]; o[3] = __uint_as_float(b.y & 0xffff0000u) + a0[3];
                    o[4] = __uint_as_float(b.z << 16) + a1[0]; o[5] = __uint_as_float(b.z & 0xffff0000u) + a1[1]; o[6] = __uint_as_float(b.w << 16) + a1[2]; o[7] = __uint_as_float(b.w & 0xffff0000u) + a1[3];
#pragma unroll
                    for (int e = 0; e < 8; ++e) sq += o[e] * o[e];
                    u32x4 w; w.x = pk_bf16(o[0], o[1]); w.y = pk_bf16(o[2], o[3]); w.z = pk_bf16(o[4], o[5]); w.w = pk_bf16(o[6], o[7]);
                    *(u32x4*)(rowp + bj * HALF) = w; }
                sq += __shfl_xor(sq, 16); sq += __shfl_xor(sq, 32);
                if (fq == 0) part[wc * 256 + (row - u.pm * BM)] = sq; }
            asm volatile("" ::: "memory"); }
#undef RES_LOAD
        PG8_LDS_BAR();
        { const int tid = (wr * 4 + wc) * 64 + fq * 16 + fr; if (tid < 256) ss[(size_t)(u.pm * BM + tid) * 8 + u.pn] = (part[tid] + part[256 + tid]) + (part[512 + tid] + part[768 + tid]); }
    }
};
__device__ __forceinline__ float dpp_f(float oldv, float src, int ctrl_sel) {
    const int o = __float_as_int(oldv), s = __float_as_int(src); int r;
    if (ctrl_sel == 0) r = __builtin_amdgcn_update_dpp(o, s, 0x111, 0xF, 0xF, false);
    else if (ctrl_sel == 1) r = __builtin_amdgcn_update_dpp(o, s, 0x101, 0xF, 0xF, false);
    else if (ctrl_sel == 2) r = __builtin_amdgcn_mov_dpp(s, 0x121, 0xF, 0xF, true);
    else r = __builtin_amdgcn_mov_dpp(s, 0x12F, 0xF, 0xF, true);
    return __int_as_float(r);
}
__device__ __forceinline__ f32x4 dpp4(const f32x4& oldv, const f32x4& src, int sel) { f32x4 r; r[0] = dpp_f(oldv[0], src[0], sel); r[1] = dpp_f(oldv[1], src[1], sel); r[2] = dpp_f(oldv[2], src[2], sel); r[3] = dpp_f(oldv[3], src[3], sel); return r; }
struct EpiUpConv {
    static constexpr bool PERM = true, AFTER_DRAIN = false;
    bf16_t* G; const float* ssp; const float* cw  ; float* epart; float* eraw; LAS3 float* xch  ; LAS3 float* rsl; LAS3 float* sspl0  ; LAS3 float* tapl0  ;
    __device__ __forceinline__ void prefetch(const Unit& u, int par, int wid, int lane) const { ssp_prefetch(ssp, u.pm, sspl0 + par * 2048, wid, lane);
        if (wid < 4) __builtin_amdgcn_global_load_lds((const unsigned*)(cw + (size_t)wid * 11264 + u.pn * BM + lane * 4), (LAS3 unsigned*)(tapl0 + par * 1024 + wid * 256), 16, 0, 0); }
    __device__ __forceinline__ void operator()(const f32x4 (&acc)[2][2][4][2], const Unit& u, int wr, int wc, int fr, int fq, int par) const {
        const LAS3 float* sspl = sspl0 + par * 2048; const LAS3 float* tapl = tapl0 + par * 1024;
        const int row0 = u.pm * BM + wr * 64 + fr, jcol = wc * 32 + 8 * fq, ncol = u.pn * BM + jcol;
        rs_table_from_lds(sspl, rsl, (wr * 4 + wc) * 64 + fq * 16 + fr);
#pragma unroll
        for (int ai = 0; ai < 2; ++ai) { const int s = 2 * ai + wr;
            if (fr == 0 && s > 0) {
#pragma unroll
                for (int bj = 0; bj < 2; ++bj)
#pragma unroll
                    for (int n = 0; n < 2; ++n) *(LAS3 f32x4*)(xch + (s * 2 - 1) * 256 + 128 * bj + jcol + 4 * n) = acc[ai][bj][0][n]; }
            if (fr == 15 && s < 3) {
#pragma unroll
                for (int bj = 0; bj < 2; ++bj)
#pragma unroll
                    for (int n = 0; n < 2; ++n) *(LAS3 f32x4*)(xch + (s * 2) * 256 + 128 * bj + jcol + 4 * n) = acc[ai][bj][3][n]; } }
        PG8_LDS_BAR();
        float rs[2][4];
#pragma unroll
        for (int ai = 0; ai < 2; ++ai)
#pragma unroll
            for (int m = 0; m < 4; ++m) rs[ai][m] = rsl[wr * 64 + fr + ai * HALF + m * 16];
        const f32x4 zero4 = {0.f, 0.f, 0.f, 0.f};
#pragma unroll
        for (int n = 0; n < 2; ++n) {
            f32x4 w0[2], w1[2], w2[2], bb[2];
#pragma unroll
            for (int bj = 0; bj < 2; ++bj) { const LAS3 float* p = tapl + 128 * bj + jcol + 4 * n; w0[bj] = *(const LAS3 f32x4*)(p); w1[bj] = *(const LAS3 f32x4*)(p + 256); w2[bj] = *(const LAS3 f32x4*)(p + 512); bb[bj] = *(const LAS3 f32x4*)(p + 768); }
#pragma unroll
            for (int ai = 0; ai < 2; ++ai) { const int s = 2 * ai + wr;
#pragma unroll
                for (int m = 0; m < 4; ++m) { f32x4 uu[2];
#pragma unroll
                    for (int bj = 0; bj < 2; ++bj) { const f32x4 x = acc[ai][bj][m][n] * rs[ai][m];
                        f32x4 fp, fn;
                        if (m > 0) { const f32x4 xm = acc[ai][bj][m > 0 ? m - 1 : 0][n] * rs[ai][m > 0 ? m - 1 : 0]; fp = dpp4(xm, xm, 2); }
                        else fp = (s > 0) ? *(const LAS3 f32x4*)(xch + (s > 0 ? 2 * s - 2 : 0) * 256 + 128 * bj + jcol + 4 * n) * rsl[s > 0 ? 64 * s - 1 : 0] : zero4;
                        if (m < 3) { const f32x4 xp = acc[ai][bj][m < 3 ? m + 1 : 3][n] * rs[ai][m < 3 ? m + 1 : 3]; fn = dpp4(xp, xp, 3); }
                        else fn = (s < 3) ? *(const LAS3 f32x4*)(xch + (s < 3 ? 2 * s + 1 : 0) * 256 + 128 * bj + jcol + 4 * n) * rsl[s < 3 ? 64 * (s + 1) : 0] : zero4;
                        const f32x4 p = dpp4(fp, x, 0), q = dpp4(fn, x, 1);
                        uu[bj] = bb[bj] + w0[bj] * p + w1[bj] * x + w2[bj] * q;
                        if (ai == 0 && m == 0) { if (wr == 0 && fr == 0) { const size_t o = (size_t)(u.pm * 2 + 0) * 11264 + ncol + 128 * bj + 4 * n; *(f32x4*)(epart + o) = uu[bj]; *(f32x4*)(eraw + o) = x; } }
                        if (ai == 1 && m == 3) { if (wr == 1 && fr == 15) { const size_t o = (size_t)(u.pm * 2 + 1) * 11264 + ncol + 128 * bj + 4 * n; *(f32x4*)(epart + o) = uu[bj]; *(f32x4*)(eraw + o) = x; } }
                    }
                    float gg[4];
#pragma unroll
                    for (int e = 0; e < 4; ++e) { const float xg = uu[0][e]; gg[e] = xg * __builtin_amdgcn_rcpf(1.0f + __builtin_amdgcn_exp2f(-1.4426950408889634f * xg)) * uu[1][e]; }
                    u32x2 w; w.x = pk_bf16(gg[0], gg[1]); w.y = pk_bf16(gg[2], gg[3]);
                    *(u32x2*)(G + (size_t)(row0 + ai * HALF + m * 16) * 5632 + u.pn * 128 + jcol + 4 * n) = w;
                    __builtin_amdgcn_sched_barrier(0);
                }
            }
        }
    }
};
template <class Epi, class Sched, bool ALIGN_EPI = false, bool SP2 = false>
__device__ __forceinline__ void gemm_phase(PG8_LAS unsigned char* lds, const Gemm g, const Sched& S, const Epi& E) {
    int tid_ = threadIdx.x; asm volatile("" : "+v"(tid_));
    const int tid = tid_, wid = __builtin_amdgcn_readfirstlane(tid >> 6), lane = tid & 63, wr = wid >> 2, wc = wid & 3, fr = lane & 15, fq = lane >> 4;
    const int K = g.K, nt = K / BK;
    unsigned voffA[2], voffB[2];
#pragma unroll
    for (int i = 0; i < 2; ++i) { int R, C; stage_rc(tid * 16 + i * 8192, R, C); const int Rb = Epi::PERM ? ((R & ~31) + perm32(R & 31)) : R;
        voffA[i] = (unsigned)(R * K + C) * 2u; voffB[i] = (unsigned)(Rb * K + C) * 2u; }
    const size_t kstep = (size_t)(BK * 2);
    const size_t hstep = (size_t)HALF * K * 2;
    const size_t tstep = 2 * hstep;
    const unsigned ldsw = (unsigned)wid * 1024u;
    const int aoff = lds_byte(wr * 64 + fr, fq * 8), boff = lds_byte(wc * 32 + fr, fq * 8);
#define PG8_SA(b, h) (((b) * 2 + (h)) * HTB)
#define PG8_SB(b, h) ((4 + (b) * 2 + (h)) * HTB)
#define PG8_STAGE(bufoff, gbase, voff) do { _Pragma("unroll") for (int _i = 0; _i < 2; ++_i) \
        __builtin_amdgcn_global_load_lds((const unsigned*)((const char*)(gbase) + (voff)[_i]), (PG8_LAS unsigned*)(lds + (bufoff) + ldsw + _i * 8192), 16, 0, 0); } while (0)
#define PG8_LDA(dst, b, h) do { _Pragma("unroll") for (int m = 0; m < 4; ++m) _Pragma("unroll") for (int k = 0; k < 2; ++k) dst[m][k] = *(const PG8_LAS bf16x8*)(lds + PG8_SA(b, h) + aoff + m * 2048 + k * 1024); } while (0)
#define PG8_LDB(dst, b, h) do { _Pragma("unroll") for (int n = 0; n < 2; ++n) _Pragma("unroll") for (int k = 0; k < 2; ++k) dst[n][k] = *(const PG8_LAS bf16x8*)(lds + PG8_SB(b, h) + boff + n * 2048 + k * 1024); } while (0)
#define PG8_MMA(ai, bj, At, Bt) do { __builtin_amdgcn_s_setprio(1); _Pragma("unroll") for (int m = 0; m < 4; ++m) _Pragma("unroll") for (int n = 0; n < 2; ++n) _Pragma("unroll") for (int k = 0; k < 2; ++k) \
        acc[ai][bj][m][n] = __builtin_amdgcn_mfma_f32_16x16x32_bf16(Bt[n][k], At[m][k], acc[ai][bj][m][n], 0, 0, 0); __builtin_amdgcn_s_setprio(0); } while (0)
#define PG8_WAIT_V(n) asm volatile("s_waitcnt vmcnt(" #n ")" ::: "memory")
#define PG8_WAIT_L(n) asm volatile("s_waitcnt lgkmcnt(" #n ")" ::: "memory")
#define PG8_BAR __builtin_amdgcn_s_barrier()
#define PG8_SCHED __builtin_amdgcn_sched_barrier(0)
    Unit cur, nxt; int ui = 0;
    if (!S.next(0, cur)) return;
    f32x4 acc[2][2][4][2];
#pragma unroll
    for (int a = 0; a < 2; ++a)
#pragma unroll
        for (int b = 0; b < 2; ++b)
#pragma unroll
            for (int m = 0; m < 4; ++m)
#pragma unroll
                for (int n = 0; n < 2; ++n) acc[a][b][m][n] = (f32x4){0.f, 0.f, 0.f, 0.f};
    bf16x8 At[4][2], B0[2][2], B1[2][2];
    const char* cA = (const char*)g.A + (size_t)cur.pm * tstep; const char* cB = (const char*)g.Bt + (size_t)cur.pn * tstep;
    S.a_ready(cur);
    E.prefetch(cur, 0, wid, lane);
    if constexpr (SP2) {
        PG8_STAGE(PG8_SB(0, 0), cB, voffB); PG8_STAGE(PG8_SB(0, 1), cB + hstep, voffB); PG8_STAGE(PG8_SA(0, 0), cA, voffA); PG8_STAGE(PG8_SA(0, 1), cA + hstep, voffA);
        if (wr == 1) PG8_BAR;
        PG8_WAIT_V(2); PG8_BAR;
        PG8_STAGE(PG8_SB(1, 0), cB + kstep, voffB); PG8_STAGE(PG8_SA(1, 0), cA + kstep, voffA); PG8_STAGE(PG8_SB(1, 1), cB + hstep + kstep, voffB);
        PG8_WAIT_V(6); PG8_BAR;
    } else {
        PG8_STAGE(PG8_SB(0, 0), cB, voffB); PG8_STAGE(PG8_SA(0, 0), cA, voffA); PG8_STAGE(PG8_SB(0, 1), cB + hstep, voffB); PG8_STAGE(PG8_SA(0, 1), cA + hstep, voffA);
        if (wr == 1) PG8_BAR;
        PG8_WAIT_V(4); PG8_BAR;
        PG8_STAGE(PG8_SB(1, 0), cB + kstep, voffB); PG8_STAGE(PG8_SA(1, 0), cA + kstep, voffA); PG8_STAGE(PG8_SB(1, 1), cB + hstep + kstep, voffB);
        PG8_WAIT_V(6); PG8_BAR;
    }
    for (;;) {
        const bool has_next = S.next(ui + 1, nxt);
        const char* nA = has_next ? (const char*)g.A + (size_t)nxt.pm * tstep : cA; const char* nB = has_next ? (const char*)g.Bt + (size_t)nxt.pn * tstep : cB;
        for (int t = 0; t < nt; t += 2) {
            const bool last = (t == nt - 2);
            const char* a1 = cA + (size_t)(t + 1) * kstep;
            const char* a2 = last ? nA : cA + (size_t)(t + 2) * kstep; const char* b2 = last ? nB : cB + (size_t)(t + 2) * kstep;
            const char* a3 = a2 + kstep; const char* b3 = b2 + kstep;
            if (last && has_next) S.a_ready(nxt);
            if constexpr (SP2) {
            PG8_LDB(B0, 0, 0); PG8_LDB(B1, 0, 1); PG8_SCHED; PG8_LDA(At, 0, 0); PG8_STAGE(PG8_SA(1, 1), a1 + hstep, voffA);
            PG8_WAIT_V(8); PG8_WAIT_L(0); PG8_BAR; PG8_MMA(0, 0, At, B0); PG8_MMA(0, 1, At, B1); PG8_BAR; PG8_SCHED;
            PG8_LDA(At, 0, 1); PG8_STAGE(PG8_SB(0, 0), b2, voffB); PG8_STAGE(PG8_SB(0, 1), b2 + hstep, voffB); PG8_STAGE(PG8_SA(0, 0), a2, voffA);
            PG8_WAIT_V(8); PG8_WAIT_L(0); PG8_BAR; PG8_MMA(1, 0, At, B0); PG8_MMA(1, 1, At, B1); PG8_BAR; PG8_SCHED;
            PG8_LDB(B0, 1, 0); PG8_LDB(B1, 1, 1); PG8_SCHED; PG8_LDA(At, 1, 0); PG8_STAGE(PG8_SA(0, 1), a2 + hstep, voffA);
            PG8_WAIT_V(8); PG8_WAIT_L(0); PG8_BAR; PG8_MMA(0, 0, At, B0); PG8_MMA(0, 1, At, B1); PG8_BAR; PG8_SCHED;
            PG8_LDA(At, 1, 1); PG8_STAGE(PG8_SB(1, 0), b3, voffB); PG8_STAGE(PG8_SB(1, 1), b3 + hstep, voffB); PG8_STAGE(PG8_SA(1, 0), a3, voffA);
            PG8_WAIT_V(8); PG8_WAIT_L(0); PG8_BAR; PG8_MMA(1, 0, At, B0); PG8_MMA(1, 1, At, B1); PG8_BAR; PG8_SCHED;
            } else {
            PG8_LDB(B0, 0, 0); PG8_SCHED; PG8_LDA(At, 0, 0); PG8_STAGE(PG8_SA(1, 1), a1 + hstep, voffA);
            PG8_WAIT_L(8); PG8_BAR; PG8_WAIT_L(0); PG8_MMA(0, 0, At, B0); PG8_BAR; PG8_SCHED;
            PG8_LDB(B1, 0, 1); PG8_STAGE(PG8_SB(0, 0), b2, voffB);
            PG8_BAR; PG8_WAIT_L(0); PG8_MMA(0, 1, At, B1); PG8_BAR;
            PG8_LDA(At, 0, 1); PG8_STAGE(PG8_SA(0, 0), a2, voffA);
            PG8_BAR; PG8_WAIT_L(0); PG8_MMA(1, 0, At, B0); PG8_BAR; PG8_SCHED;
            PG8_STAGE(PG8_SB(0, 1), b2 + hstep, voffB);
            PG8_WAIT_V(6); PG8_BAR; PG8_MMA(1, 1, At, B1); PG8_BAR;
            PG8_LDB(B0, 1, 0); PG8_SCHED; PG8_LDA(At, 1, 0); PG8_STAGE(PG8_SA(0, 1), a2 + hstep, voffA);
            PG8_WAIT_L(8); PG8_BAR; PG8_WAIT_L(0); PG8_MMA(0, 0, At, B0); PG8_BAR; PG8_SCHED;
            PG8_LDB(B1, 1, 1); PG8_STAGE(PG8_SB(1, 0), b3, voffB);
            PG8_BAR; PG8_WAIT_L(0); PG8_MMA(0, 1, At, B1); PG8_BAR;
            PG8_LDA(At, 1, 1); PG8_STAGE(PG8_SA(1, 0), a3, voffA);
            PG8_BAR; PG8_WAIT_L(0); PG8_MMA(1, 0, At, B0); PG8_BAR; PG8_SCHED;
            PG8_STAGE(PG8_SB(1, 1), b3 + hstep, voffB);
            PG8_WAIT_V(6); PG8_BAR; PG8_MMA(1, 1, At, B1); PG8_BAR;
            }
        }
        if constexpr (ALIGN_EPI) { if (wr == 0) PG8_BAR; }
        if constexpr (!Epi::AFTER_DRAIN) { E(acc, cur, wr, wc, fr, fq, ui & 1); S.done(cur); }
        if (!has_next) break;
#pragma unroll
        for (int a = 0; a < 2; ++a)
#pragma unroll
            for (int b = 0; b < 2; ++b)
#pragma unroll
                for (int m = 0; m < 4; ++m)
#pragma unroll
                    for (int n = 0; n < 2; ++n) acc[a][b][m][n] = (f32x4){0.f, 0.f, 0.f, 0.f};
        cur = nxt; cA = nA; cB = nB; ++ui;
        E.prefetch(cur, ui & 1, wid, lane);
        if constexpr (ALIGN_EPI) { if (wr == 1) PG8_BAR; }
    }
    PG8_WAIT_V(0);
    if constexpr (!ALIGN_EPI) { if (wr == 0) PG8_BAR; }
    PG8_BAR;
    if constexpr (Epi::AFTER_DRAIN) { E.fused(acc, cur, wr, wc, fr, fq, lds, wid, lane); S.done(cur); }
#undef PG8_SA
#undef PG8_SB
#undef PG8_STAGE
#undef PG8_LDA
#undef PG8_LDB
#undef PG8_MMA
#undef PG8_WAIT_V
#undef PG8_WAIT_L
#undef PG8_BAR
#undef PG8_SCHED
}
}

#define LAS __attribute__((address_space(3)))
#define GAS __attribute__((address_space(1)))
typedef unsigned short bf16_t;
typedef short bf16x8 __attribute__((ext_vector_type(8)));
typedef short s16x4 __attribute__((ext_vector_type(4)));
typedef float f32x4 __attribute__((ext_vector_type(4)));
typedef float f32x2 __attribute__((ext_vector_type(2)));
typedef float f32x16 __attribute__((ext_vector_type(16)));
typedef unsigned u32x4 __attribute__((ext_vector_type(4)));
typedef unsigned u32x2 __attribute__((ext_vector_type(2)));
using pg8::pk_bf16;

constexpr int NWAVES = 8, NTHREADS = 512;
constexpr int M = 16384, T = 2048, D = 2048, NIN = 5120, DFF = 5632, NUP = 11264;
constexpr int MH = M / 2;
constexpr float LOG2E = 1.4426950408889634f;
constexpr float EPS = 1e-6f;
constexpr size_t MiB = 1u << 20;
constexpr size_t WS_BAR = 448 * 1024;
constexpr size_t WS_AL = 2 * MiB;
constexpr size_t WS_CW = 5 * MiB;
constexpr size_t WS_WIN = 8 * MiB;
constexpr size_t WS_WOUT = 48 * MiB;
constexpr size_t WS_WUP = 64 * MiB;
constexpr size_t WS_WDOWN = 152 * MiB;
constexpr size_t WS_XB = 196 * MiB;
constexpr size_t WS_BIG = 260 * MiB;
constexpr size_t WS_PROJ = WS_BIG;
constexpr size_t WS_AO = WS_BIG + 160 * MiB;
constexpr size_t WS_MIX = WS_BIG + 232 * MiB;
constexpr size_t WS_EPART = WS_BIG;
constexpr size_t WS_ERAW = WS_BIG + 8 * MiB;
constexpr size_t WS_G = WS_BIG + 176 * MiB;
constexpr size_t WS_SSP = WS_BIG + 352 * MiB;
constexpr size_t WS_END = WS_SSP + 12 * MiB;
constexpr int LDS_BYTES = 163840;

__device__ __forceinline__ float bf2f(unsigned short b) { return __uint_as_float((unsigned)b << 16); }
__device__ __forceinline__ float bflo(unsigned w) { return __uint_as_float(w << 16); }
__device__ __forceinline__ float bfhi(unsigned w) { return __uint_as_float(w & 0xffff0000u); }
__device__ __forceinline__ float wave_sum(float v) {
#pragma unroll
    for (int o = 1; o < 64; o <<= 1) v += __shfl_xor(v, o);
    return v;
}

template <int MODE> __device__ __forceinline__ int dst_row(int n) {
    if (MODE == 1) { if (n < 1536 || (n >= 2304 && n < 3072)) { const int d = n & 63; return (n & ~63) + 2 * (d & 31) + (d >> 5); } return n; }
    if (MODE == 2) { const int p = n >= 5632 ? 1 : 0, n2 = n - 5632 * p; return 256 * (n2 >> 7) + 128 * p + (n2 & 127); }
    return n;
}
template <int MODE, bool HASGAIN = true> __device__ __forceinline__ void transpose_item(const float* W, int K, int N, bf16_t* WT, const float* gain, LAS unsigned* scr, int item, int lane) {
    const int nblk = N / 64, kb = item / nblk, nb = item % nblk, k0 = 64 * kb, n0 = 64 * nb;
    const int c4 = (lane & 15) * 4, pr = lane >> 4;
    f32x4 av[8], bv[8]; f32x2 gg[8];
    const float* p0 = W + (size_t)(k0 + 2 * pr) * N + n0 + c4;
#pragma unroll
    for (int i = 0; i < 8; ++i) { const float* p = p0 + (size_t)(8 * i) * N; av[i] = __builtin_nontemporal_load((const f32x4*)p); bv[i] = __builtin_nontemporal_load((const f32x4*)(p + N)); }
#pragma unroll
    for (int i = 0; i < 8; ++i) { if (HASGAIN) gg[i] = *(const f32x2*)(gain + k0 + 2 * (4 * i + pr)); else gg[i] = (f32x2){1.f, 1.f}; }
    asm volatile("" ::: "memory");
#pragma unroll
    for (int i = 0; i < 8; ++i) { const int kk2 = 4 * i + pr; const f32x4 a = av[i] * gg[i].x, b = bv[i] * gg[i].y;
        u32x2 lo, hi; lo.x = pk_bf16(a[0], b[0]); lo.y = pk_bf16(a[1], b[1]); hi.x = pk_bf16(a[2], b[2]); hi.y = pk_bf16(a[3], b[3]);
        *(LAS u32x2*)(scr + kk2 * 66 + c4) = lo; *(LAS u32x2*)(scr + kk2 * 66 + c4 + 2) = hi; }
    asm volatile("s_waitcnt lgkmcnt(0)" ::: "memory");
    const int c = lane & 7;
#pragma unroll
    for (int j = 0; j < 8; ++j) { const int n = (lane >> 3) + 8 * j; const LAS unsigned* q = scr + (4 * c) * 66 + n;
        u32x4 o; o.x = q[0]; o.y = q[66]; o.z = q[132]; o.w = q[198];
        *(u32x4*)(WT + (size_t)dst_row<MODE>(n0 + n) * K + k0 + 8 * c) = o; }
    asm volatile("s_waitcnt lgkmcnt(0)" ::: "memory");
}

constexpr int KSTR = 144;
constexpr int WAVE_LDS = 11264;
__device__ __forceinline__ int crow(int i, int h) { return (i & 3) + 8 * (i >> 2) + 4 * h; }

struct PolA {
    int tokbase, r, rho, jb, L;
    __device__ __forceinline__ int ntiles() const { return 5; }
    __device__ __forceinline__ bool tile_ok(int kt) const { const int j0 = jb - 64 + 32 * kt; return j0 >= 0 && j0 < L; }
    __device__ __forceinline__ int key_tok(int kt, int rowi) const { return tokbase + (jb - 64 + 32 * kt + rowi) * r + rho; }
    __device__ __forceinline__ int q_tok(int rq) const { return tokbase + (jb + rq) * r + rho; }
    __device__ __forceinline__ bool needs_mask(int kt) const { return kt == 0 || kt == 4; }
    __device__ __forceinline__ bool valid(int kt, int kv, int rq) const { const int d = 32 * kt - 64 + kv - rq; return (unsigned)(d + 64) <= 128u; }
    __device__ __forceinline__ float bias(int, int) const { return 0.f; }
};
struct PolB {
    int tokbase, q0;
    __device__ __forceinline__ int ntiles() const { return 9; }
    __device__ __forceinline__ bool tile_ok(int kt) const { const int t0 = q0 - 128 + 32 * kt; return t0 >= 0 && t0 < T; }
    __device__ __forceinline__ int key_tok(int kt, int rowi) const { return tokbase + q0 - 128 + 32 * kt + rowi; }
    __device__ __forceinline__ int q_tok(int rq) const { return tokbase + q0 + rq; }
    __device__ __forceinline__ bool needs_mask(int kt) const { return kt == 0 || kt == 8; }
    __device__ __forceinline__ bool valid(int kt, int kv, int rq) const { const int d = 32 * kt - 128 + kv - rq; return (unsigned)(d + 128) <= 256u; }
    __device__ __forceinline__ float bias(int, int) const { return 0.f; }
};
struct PolC {
    int tokbase, Rp, cb, rs0, kc0, nt;
    int Rq, c, rsq, csq;
    const LAS float* tab;
    __device__ __forceinline__ int ntiles() const { return nt; }
    __device__ __forceinline__ bool tile_ok(int kt) const { return rs0 + kt <= 31; }
    __device__ __forceinline__ int key_tok(int kt, int rowi) const { return tokbase + (rs0 + kt) * 64 + kc0 + rowi; }
    __device__ __forceinline__ int q_tok(int rq) const { return tokbase + (2 * Rp + (rq >> 4)) * 64 + 16 * cb + (rq & 15); }
    __device__ __forceinline__ bool needs_mask(int) const { return true; }
    __device__ __forceinline__ bool valid(int kt, int kv, int) const { const int kr = rs0 + kt; return (unsigned)(kr - rsq) < 8u && (unsigned)(kv + kc0 - csq) < 16u; }
    __device__ __forceinline__ float bias(int kt, int kv) const { const int idx = (rs0 + kt - Rq + 7) * 31 + (kc0 - c + 15) + kv; return tab[idx < 0 ? 0 : (idx > 464 ? 464 : idx)]; }
};

template <class Pol, bool HASBIAS> __device__ __forceinline__ void attn_tile(const Pol& P, int kt, LAS unsigned char* Kb, LAS unsigned char* Vb, const bf16x8 (&qf)[4], float& m, float& l, f32x16 (&o)[2], int lane) {
    const int r = lane & 31, h = lane >> 5;
    const int i16 = lane & 15, tq = i16 >> 2, tp = i16 & 3, blk = (lane >> 4) & 1;
    f32x16 s;
#pragma unroll
    for (int i = 0; i < 16; ++i) s[i] = 0.f;
#pragma unroll
    for (int ds = 0; ds < 4; ++ds) { const bf16x8 a = *(const LAS bf16x8*)(Kb + r * KSTR + ds * 32 + h * 16); s = __builtin_amdgcn_mfma_f32_32x32x16_bf16(a, qf[ds], s, 0, 0, 0); }
    float tm = -1e30f;
    if (P.needs_mask(kt)) {
#pragma unroll
        for (int i = 0; i < 16; ++i) { const int kv = crow(i, h); float v = s[i]; if (HASBIAS) v += P.bias(kt, kv); v = P.valid(kt, kv, r) ? v : -1e30f; s[i] = v; tm = fmaxf(tm, v); }
    } else {
#pragma unroll
        for (int i = 0; i < 16; ++i) tm = fmaxf(tm, s[i]);
    }
    tm = fmaxf(tm, __shfl_xor(tm, 32));
    if (__any(tm > m + 12.0f)) {

        const float mn = fmaxf(m, tm), alpha = __builtin_amdgcn_exp2f(m - mn); m = mn; l *= alpha;
#pragma unroll
        for (int i = 0; i < 16; ++i) { o[0][i] *= alpha; o[1][i] *= alpha; }
    }
    float ps = 0.f;
#pragma unroll
    for (int i = 0; i < 16; ++i) { s[i] = __builtin_amdgcn_exp2f(s[i] - m); ps += s[i]; }
    l += ps;
    bf16x8 pb[2];
#pragma unroll
    for (int s2 = 0; s2 < 2; ++s2) { u32x4 w; w.x = pk_bf16(s[8 * s2 + 0], s[8 * s2 + 1]); w.y = pk_bf16(s[8 * s2 + 2], s[8 * s2 + 3]); w.z = pk_bf16(s[8 * s2 + 4], s[8 * s2 + 5]); w.w = pk_bf16(s[8 * s2 + 6], s[8 * s2 + 7]); pb[s2] = __builtin_bit_cast(bf16x8, w); }
#pragma unroll
    for (int dt = 0; dt < 2; ++dt)
#pragma unroll
        for (int s2 = 0; s2 < 2; ++s2) {
            typedef short v4i16_t __attribute__((ext_vector_type(4)));
            LAS unsigned char* pa = Vb + (16 * s2 + 4 * h + tq) * KSTR + (32 * dt + 16 * blk) * 2 + 8 * tp;
            const s16x4 lo = __builtin_bit_cast(s16x4, __builtin_amdgcn_ds_read_tr16_b64_v4i16((LAS v4i16_t*)pa));
            const s16x4 hi = __builtin_bit_cast(s16x4, __builtin_amdgcn_ds_read_tr16_b64_v4i16((LAS v4i16_t*)(pa + 8 * KSTR)));
            const bf16x8 a = __builtin_shufflevector(lo, hi, 0, 1, 2, 3, 4, 5, 6, 7);
            o[dt] = __builtin_amdgcn_mfma_f32_32x32x16_bf16(a, pb[s2], o[dt], 0, 0, 0);
        }
}
template <class Pol, bool HASBIAS> __device__ __forceinline__ void attn_run(const Pol& P, LAS unsigned char* wl, const bf16_t* proj, int qcol, int kcol, int vcol, int lane, float& m_out, float& l_out, f32x16 (&o)[2]) {
    const int r = lane & 31, h = lane >> 5;
    const bf16_t* qp = proj + (size_t)P.q_tok(r) * NIN + qcol + 8 * h;
    bf16x8 qf[4];
#pragma unroll
    for (int ds = 0; ds < 4; ++ds) qf[ds] = *(const bf16x8*)(qp + 16 * ds);
    float m = -5e29f, l = 0.f;
#pragma unroll
    for (int i = 0; i < 16; ++i) { o[0][i] = 0.f; o[1][i] = 0.f; }
    const int srow = lane >> 3, sch = lane & 7;
    LAS unsigned char* Kb = wl; LAS unsigned char* Vb = wl + 4608;
    int lo = 0, hi = P.ntiles() - 1;
    while (lo <= hi && !P.tile_ok(lo)) ++lo;
    while (hi >= lo && !P.tile_ok(hi)) --hi;
    u32x4 ka[4], va[4], kb[4], vb[4];
#define ATT_LOAD(KR, VR, KT) do { _Pragma("unroll") for (int i = 0; i < 4; ++i) { const unsigned off = (unsigned)P.key_tok((KT), i * 8 + srow) * (unsigned)(NIN * 2) + (unsigned)(sch * 16); \
        KR[i] = *(const u32x4*)((const char*)proj + (off + (unsigned)(kcol * 2))); VR[i] = *(const u32x4*)((const char*)proj + (off + (unsigned)(vcol * 2))); } } while (0)
#define ATT_STEP(KR, VR, KT) do { _Pragma("unroll") for (int i = 0; i < 4; ++i) { *(LAS u32x4*)(Kb + (i * 8 + srow) * KSTR + sch * 16) = KR[i]; *(LAS u32x4*)(Vb + (i * 8 + srow) * KSTR + sch * 16) = VR[i]; } \
        if ((KT) + 2 <= hi) ATT_LOAD(KR, VR, (KT) + 2); \
        asm volatile("" ::: "memory"); attn_tile<Pol, HASBIAS>(P, (KT), Kb, Vb, qf, m, l, o, lane); asm volatile("" ::: "memory"); } while (0)
    if (lo <= hi) ATT_LOAD(ka, va, lo);
    if (lo + 1 <= hi) ATT_LOAD(kb, vb, lo + 1);
    for (int kt = lo; kt <= hi; kt += 2) {
        ATT_STEP(ka, va, kt);
        if (kt + 1 <= hi) ATT_STEP(kb, vb, kt + 1);
    }
#undef ATT_LOAD
#undef ATT_STEP
    l += __shfl_xor(l, 32);
    m_out = m; l_out = l;
}
__device__ __forceinline__ void attn_store(const f32x16 (&o)[2], float scale, bf16_t* rowp, int h) {
#pragma unroll
    for (int dt = 0; dt < 2; ++dt)
#pragma unroll
        for (int g = 0; g < 4; ++g) { u32x2 w; w.x = pk_bf16(o[dt][4 * g] * scale, o[dt][4 * g + 1] * scale); w.y = pk_bf16(o[dt][4 * g + 2] * scale, o[dt][4 * g + 3] * scale);
            *(u32x2*)(rowp + 32 * dt + 8 * g + 4 * h) = w; }
}

constexpr int N_ITEMS_A = 3 * 8 * 12 * 64, N_ITEMS_B = 8 * 10 * 64, N_ITEMS_C = 8 * 10 * 16 * 4;

__device__ __forceinline__ void attn_phase(LAS unsigned char* lds, const bf16_t* proj, bf16_t* Ao, float* Al, bf16_t* mixed, const float* sink, const float* rpb, int gw, int ngw, int wave, int lane) {
    LAS unsigned char* wl = lds + wave * WAVE_LDS;
    const int r = lane & 31, h = lane >> 5;
    for (int it = gw; it < N_ITEMS_B + N_ITEMS_C; it += ngw) {
        if (it < N_ITEMS_B) {
            const int bh = it >> 6, qb = ((it & 63) + 13 * (bh >> 5)) & 63, b = bh / 10, hq = bh % 10, kvh = hq / 5;
            PolB P; P.tokbase = b * T; P.q0 = 32 * qb;
            float m, l; f32x16 o[2];
            attn_run<PolB, false>(P, wl, proj, 2304 + hq * 64, 2944 + kvh * 64, 3072 + kvh * 64, lane, m, l, o);
            const float den = l + __builtin_amdgcn_exp2f(sink[hq] * LOG2E - m);
            attn_store(o, 1.0f / den, mixed + (size_t)P.q_tok(r) * D + 768 + hq * 64, h);
        } else {
            const int ic = it - N_ITEMS_B, cb = ic & 3, Rp = (ic >> 2) & 15, bh = ic >> 6, b = bh / 10, hd = bh % 10;
            LAS float* tab = (LAS float*)(wl + 9216);
            for (int i = lane; i < 465; i += 64) tab[i] = rpb[hd * 465 + i] * LOG2E;
            PolC P; P.tokbase = b * T; P.Rp = Rp; P.cb = cb; { int s = 2 * Rp - 4; P.rs0 = s < 0 ? 0 : (s > 24 ? 24 : s); } { int s1 = 2 * Rp + 1 - 4; s1 = s1 < 0 ? 0 : (s1 > 24 ? 24 : s1); P.nt = s1 + 8 - P.rs0; } { int s = 16 * cb - 8; P.kc0 = s < 0 ? 0 : (s > 32 ? 32 : s); }
            P.Rq = 2 * Rp + (r >> 4); P.c = 16 * cb + (r & 15); { int s = P.Rq - 4; P.rsq = s < 0 ? 0 : (s > 24 ? 24 : s); } { int s = P.c - 8; P.csq = s < 0 ? 0 : (s > 48 ? 48 : s); }
            P.tab = tab;
            float m, l; f32x16 o[2];
            attn_run<PolC, true>(P, wl, proj, 3200 + hd * 64, 3840 + hd * 64, 4480 + hd * 64, lane, m, l, o);
            attn_store(o, 1.0f / l, mixed + (size_t)P.q_tok(r) * D + 1408 + hd * 64, h);
        }
    }
    for (int it = gw; it < N_ITEMS_A; it += ngw) {
        const int c = it / 6144, rem = it % 6144, bh = rem >> 6, b = bh / 12, hd = bh % 12;
        const int w = ((rem & 63) + 11 * (bh >> 5) + 23 * c) & 63;
        const int rr = (c == 0) ? 1 : (c == 1 ? 4 : 16), nblk = 64 / rr;
        PolA P; P.tokbase = b * T; P.r = rr; P.rho = w / nblk; P.jb = 32 * (w % nblk); P.L = T / rr;
        float m, l; f32x16 o[2];
        attn_run<PolA, false>(P, wl, proj, hd * 64, 768 + hd * 64, 1536 + hd * 64, lane, m, l, o);
        const int tok = P.q_tok(r);
        attn_store(o, 1.0f / l, Ao + ((size_t)c * M + tok) * 768 + hd * 64, h);
        if (h == 0) Al[((size_t)c * M + tok) * 12 + hd] = m + __builtin_amdgcn_logf(l);
    }
}

__device__ __forceinline__ void mixnorm_phase(const bf16_t* Ao, const float* Al, bf16_t* mixed, int gw, int ngw, int lane) {
    for (int t = gw; t < M; t += ngw) {
        bf16_t* mrow = mixed + (size_t)t * D;
        u32x2 ab[3][3]; float ls[3][3]; u32x2 gb[2][3];
#pragma unroll
        for (int j = 0; j < 3; ++j) { const int c4 = (j * 64 + lane) * 4, hd = c4 >> 6;
#pragma unroll
            for (int c = 0; c < 3; ++c) { ab[c][j] = *(const u32x2*)(Ao + ((size_t)c * M + t) * 768 + c4); ls[c][j] = Al[((size_t)c * M + t) * 12 + hd]; } }
#pragma unroll
        for (int grp = 0; grp < 2; ++grp)
#pragma unroll
            for (int j = 0; j < 3; ++j) { const int ch = j * 64 + lane; gb[grp][j] = (u32x2){0u, 0u}; if (ch < 160) gb[grp][j] = *(const u32x2*)(mrow + 768 + 640 * grp + ch * 4); }
        asm volatile("" ::: "memory");
        float va[3][4]; float sa = 0.f;
#pragma unroll
        for (int j = 0; j < 3; ++j) {
            const float l0 = ls[0][j], l1 = ls[1][j], l2 = ls[2][j];
            const float mx = fmaxf(l0, fmaxf(l1, l2)); float w0 = __builtin_amdgcn_exp2f(l0 - mx), w1 = __builtin_amdgcn_exp2f(l1 - mx), w2 = __builtin_amdgcn_exp2f(l2 - mx);
            const float inv = 1.0f / (w0 + w1 + w2); w0 *= inv; w1 *= inv; w2 *= inv;
            const u32x2 a0 = ab[0][j], a1 = ab[1][j], a2 = ab[2][j];
            va[j][0] = w0 * bflo(a0.x) + w1 * bflo(a1.x) + w2 * bflo(a2.x); va[j][1] = w0 * bfhi(a0.x) + w1 * bfhi(a1.x) + w2 * bfhi(a2.x);
            va[j][2] = w0 * bflo(a0.y) + w1 * bflo(a1.y) + w2 * bflo(a2.y); va[j][3] = w0 * bfhi(a0.y) + w1 * bfhi(a1.y) + w2 * bfhi(a2.y);
            sa += (va[j][0] * va[j][0] + va[j][1] * va[j][1]) + (va[j][2] * va[j][2] + va[j][3] * va[j][3]); }
        float v[2][3][4]; float sg[2] = {0.f, 0.f};
#pragma unroll
        for (int grp = 0; grp < 2; ++grp)
#pragma unroll
            for (int j = 0; j < 3; ++j) { const u32x2 a = gb[grp][j]; v[grp][j][0] = bflo(a.x); v[grp][j][1] = bfhi(a.x); v[grp][j][2] = bflo(a.y); v[grp][j][3] = bfhi(a.y);
                sg[grp] += (v[grp][j][0] * v[grp][j][0] + v[grp][j][1] * v[grp][j][1]) + (v[grp][j][2] * v[grp][j][2] + v[grp][j][3] * v[grp][j][3]); }
        const float rsa = __builtin_amdgcn_rsqf(wave_sum(sa) * (1.0f / 768.0f) + EPS);
        const float rsg0 = __builtin_amdgcn_rsqf(wave_sum(sg[0]) * (1.0f / 640.0f) + EPS), rsg1 = __builtin_amdgcn_rsqf(wave_sum(sg[1]) * (1.0f / 640.0f) + EPS);
#pragma unroll
        for (int j = 0; j < 3; ++j) { u32x2 w; w.x = pk_bf16(va[j][0] * rsa, va[j][1] * rsa); w.y = pk_bf16(va[j][2] * rsa, va[j][3] * rsa); *(u32x2*)(mrow + (j * 64 + lane) * 4) = w; }
#pragma unroll
        for (int grp = 0; grp < 2; ++grp) { const float rsg = grp ? rsg1 : rsg0;
#pragma unroll
            for (int j = 0; j < 3; ++j) { const int ch = j * 64 + lane; if (ch < 160) { u32x2 w; w.x = pk_bf16(v[grp][j][0] * rsg, v[grp][j][1] * rsg); w.y = pk_bf16(v[grp][j][2] * rsg, v[grp][j][3] * rsg); *(u32x2*)(mrow + 768 + 640 * grp + ch * 4) = w; } } }
    }
}
typedef GAS unsigned gu32;
typedef GAS unsigned long long gu64;
#define RLX_AGENT __ATOMIC_RELAXED, __HIP_MEMORY_SCOPE_AGENT
#define XB_TMO      128
#define XB_XCNT(j)  (256  + 64 * (j))
#define XB_XSUB(j)  (1280 + 64 * (j))
#define XB_XGEN(j)  (2304 + 64 * (j))
#define XB_TOP      3328
#define XB_TOPGEN   3392
#define XCD_BAR_WORDS 3456
#define XB_SPIN_CAP (1u << 18)

__device__ __forceinline__ unsigned xb_ld(unsigned* p)              { return __hip_atomic_load(p, __ATOMIC_RELAXED, __HIP_MEMORY_SCOPE_AGENT); }
__device__ __forceinline__ unsigned xb_add(unsigned* p, unsigned v) { return __hip_atomic_fetch_add(p, v, __ATOMIC_RELAXED, __HIP_MEMORY_SCOPE_AGENT); }
__device__ __forceinline__ unsigned xb_xcc_id() { return (unsigned)__builtin_amdgcn_s_getreg((3 << 11) | 20) & 0xFu; }
#define XB_SPIN(cond, bar) do { unsigned _sp = 0; while (cond) { __builtin_amdgcn_s_sleep(1); \
    if ((++_sp & 255u) == 0u) { if (xb_ld(&(bar)[XB_TMO])) break; if (_sp > XB_SPIN_CAP) { atomicAdd(&(bar)[XB_TMO], 1u); break; } } } } while (0)

struct XcdBarrier {
    unsigned* bar; unsigned x;
    volatile LAS unsigned* st;
};

__device__ __forceinline__ XcdBarrier xcd_barrier_post(unsigned* bar, volatile LAS unsigned* st) {
    XcdBarrier b; b.bar = bar; b.x = xb_xcc_id(); b.st = st;
    if (threadIdx.x == 0) (void)xb_add(&bar[XB_XCNT(b.x)], 1u);
    return b;
}
__device__ __forceinline__ void xcd_barrier_complete(unsigned* bar, unsigned x, unsigned& nloc, unsigned& nx) {
    const unsigned G = gridDim.x * gridDim.y * gridDim.z;
    unsigned sum, cnt, mine, sp = 0u;
    for (;;) {
        sum = 0u; cnt = 0u; mine = 0u;
#pragma unroll
        for (unsigned j = 0; j < 16; ++j) { const unsigned c = xb_ld(&bar[XB_XCNT(j)]); sum += c; cnt += (c > 0u) ? 1u : 0u; mine = (j == x) ? c : mine; }
        if (sum == G) break;
        __builtin_amdgcn_s_sleep(1);
        if ((++sp & 255u) == 0u) { if (xb_ld(&bar[XB_TMO])) break; if (sp > XB_SPIN_CAP) { atomicAdd(&bar[XB_TMO], 1u); break; } }
    }
    nloc = mine > 0u ? mine : 1u; nx = cnt > 0u ? cnt : 1u;
}

__device__ __forceinline__ void xcd_barrier(const XcdBarrier& b) {
    asm volatile("s_waitcnt vmcnt(0)" ::: "memory");
    __syncthreads();
    if (threadIdx.x == 0) {
        unsigned* bar = b.bar;
        __builtin_amdgcn_s_waitcnt(0);
        unsigned nloc = b.st[0], nx = b.st[1];
        if (nloc == 0u) { xcd_barrier_complete(bar, b.x, nloc, nx); b.st[0] = nloc; b.st[1] = nx; }
        const unsigned old = xb_add(&bar[XB_XSUB(b.x)], 1u);
        const unsigned gen = old / nloc;
        if (old + 1u == (gen + 1u) * nloc) {
            __builtin_amdgcn_fence(__ATOMIC_RELEASE, "agent");
            asm volatile("s_waitcnt vmcnt(0)" ::: "memory");
            const unsigned og = xb_add(&bar[XB_TOP], 1u);
            const unsigned tg = og / nx;
            if (og + 1u == (tg + 1u) * nx) xb_add(&bar[XB_TOPGEN], 1u);
            else XB_SPIN(xb_ld(&bar[XB_TOPGEN]) == tg, bar);
            __builtin_amdgcn_fence(__ATOMIC_ACQUIRE, "agent");
            xb_add(&bar[XB_XGEN(b.x)], 1u);
            asm volatile("s_waitcnt vmcnt(0)" ::: "memory");
        } else {
            XB_SPIN(xb_ld(&bar[XB_XGEN(b.x)]) == gen, bar);
            __builtin_amdgcn_fence(__ATOMIC_ACQUIRE, "agent");
            asm volatile("s_waitcnt vmcnt(0)" ::: "memory");
        }
    }
    __syncthreads();
}

struct Args { const float* in[13]; float* out; unsigned char* ws; };
__global__ void __launch_bounds__(NTHREADS, 2) fwd_kernel(Args a) {
    extern __shared__ __attribute__((aligned(16))) unsigned char lds_raw[];
    cg::grid_group grid = cg::this_grid();
    LAS unsigned char* lds = (LAS unsigned char*)lds_raw;
    const int tid = threadIdx.x, lane = tid & 63, wave = __builtin_amdgcn_readfirstlane(tid >> 6);
    const int G = gridDim.x, gw = blockIdx.x * NWAVES + wave, ngw = G * NWAVES, gt = blockIdx.x * NTHREADS + tid, ngt = G * NTHREADS;
#define GSYNC() do { XcdBarrier xb_; xb_.bar = (unsigned*)WSP(WS_BAR); xb_.x = xb_xcc_id(); xb_.st = (volatile LAS unsigned*)(lds + 131072 + 512); xcd_barrier(xb_); } while (0)
    LAS unsigned* PT = (LAS unsigned*)(lds + 131072 + 256);
    if (tid < 15) { const unsigned long long v = (tid < 13) ? (unsigned long long)a.in[tid] : (tid == 13 ? (unsigned long long)a.out : (unsigned long long)a.ws); PT[2 * tid] = (unsigned)v; PT[2 * tid + 1] = (unsigned)(v >> 32); }
    if (tid < 2) ((LAS unsigned*)(lds + 131072 + 512))[tid] = 0u;
    __syncthreads();
#define GPTR(i) ({ unsigned ptb_ = 131072 + 256; asm volatile("" : "+v"(ptb_));   \
    volatile LAS unsigned* ptp_ = (volatile LAS unsigned*)(lds + ptb_); \
    (GAS unsigned char*)(((unsigned long long)(unsigned)__builtin_amdgcn_readfirstlane(ptp_[2 * (i) + 1]) << 32) | (unsigned)__builtin_amdgcn_readfirstlane(ptp_[2 * (i)])); })
#define INF(i) ((const float*)GPTR(i))
#define OUTP ((float*)GPTR(13))
#define WSP(off) ((unsigned char*)GPTR(14) + (off))
#define x_in INF(0)
#define sink_b INF(3)
#define rpb_c INF(4)
#define conv_w INF(9)
#define conv_b INF(10)
#define ln_final INF(12)
#define out OUTP
#define SS ((float*)WSP(WS_SSP))
#define AL ((float*)WSP(WS_AL))
#define XB ((bf16_t*)WSP(WS_XB))
#define PROJ ((bf16_t*)WSP(WS_PROJ))
#define AO ((bf16_t*)WSP(WS_AO))
#define MIX ((bf16_t*)WSP(WS_MIX))
#define EPART ((float*)WSP(WS_EPART))
#define ERAW ((float*)WSP(WS_ERAW))
#define CWT ((float*)WSP(WS_CW))
#define GB ((bf16_t*)WSP(WS_G))
    {
        LAS unsigned* scr = (LAS unsigned*)(lds + wave * 16384);
        constexpr int I_IN = (D / 64) * (NIN / 64), I_OUT = (D / 64) * (D / 64), I_UP = (D / 64) * (NUP / 64), I_DN = (DFF / 64) * (D / 64);
        for (int it = gw; it < I_IN; it += ngw) transpose_item<1>(INF(2), D, NIN, (bf16_t*)WSP(WS_WIN), INF(1), scr, it, lane);
        const float* xin_ = x_in; bf16_t* xb_ = XB; float* ss_ = SS;
        for (int m = gw; m < M; m += ngw) {
            const f32x4* xr = (const f32x4*)(xin_ + (size_t)m * D) + lane; float s = 0.f; u32x2* o8 = (u32x2*)(xb_ + (size_t)m * D) + lane; f32x4 xv[8];
#pragma unroll
            for (int j = 0; j < 8; ++j) xv[j] = __builtin_nontemporal_load(xr + 64 * j);
#pragma unroll
            for (int j = 0; j < 8; ++j) { const f32x4 v = xv[j]; s += (v[0] * v[0] + v[1] * v[1]) + (v[2] * v[2] + v[3] * v[3]); u32x2 w; w.x = pk_bf16(v[0], v[1]); w.y = pk_bf16(v[2], v[3]); o8[64 * j] = w; }
            s = wave_sum(s); if (lane < 8) ss_[(size_t)m * 8 + lane] = (lane == 0) ? s : 0.f;
        }
        { float* cwt = CWT; const float* cwi = conv_w; const float* cbi = conv_b;
          for (int i = gt; i < 2 * 4 * NUP; i += ngt) { const int l = i / (4 * NUP), k = (i / NUP) & 3, np = i % NUP, pn = np >> 8, bj = (np >> 7) & 1, j = np & 127, src = bj * DFF + pn * 128 + j;
            cwt[i] = (k < 3) ? cwi[((size_t)l * 3 + k) * NUP + src] : cbi[(size_t)l * NUP + src]; } }
        if (blockIdx.x == 0) { unsigned* bw = (unsigned*)WSP(WS_BAR); for (int i = tid; i < XCD_BAR_WORDS; i += NTHREADS) bw[i] = 0u; }
    }
    grid.sync();
    (void)xcd_barrier_post((unsigned*)WSP(WS_BAR), (volatile LAS unsigned*)(lds + 131072 + 512));

#define CONVERT_SET(FIRST_L, WITH_IN) do { const int j_ = bid_ >> 3; \
        if (G_ != 256 || (j_ & 1)) { LAS unsigned* scr = (LAS unsigned*)(lds + wave_ * 16384); const int ow = (G_ == 256) ? ((bid_ & 7) * 16 + (j_ >> 1)) * NWAVES + wave_ : gw_, now = (G_ == 256) ? 128 * NWAVES : ngw_;     \
            constexpr int I_IN = (D / 64) * (NIN / 64), I_OUT = (D / 64) * (D / 64), I_UP = (D / 64) * (NUP / 64), I_DN = (DFF / 64) * (D / 64); \
            const int l_ = (FIRST_L); const int tot = ((WITH_IN) ? I_IN : 0) + I_OUT + I_UP + I_DN; \
            for (int it = ow; it < tot; it += now) { int r = it; \
                if (WITH_IN) { if (r < I_IN) { transpose_item<1>(INF(2) + (size_t)l_ * D * NIN, D, NIN, (bf16_t*)WSP(WS_WIN) + (size_t)l_ * NIN * D, INF(1) + l_ * D, scr, r, lane_); continue; } r -= I_IN; } \
                if (r < I_OUT) { transpose_item<0>(INF(6) + (size_t)l_ * D * D, D, D, (bf16_t*)WSP(WS_WOUT) + (size_t)l_ * D * D, INF(5) + l_ * D, scr, r, lane_); continue; } r -= I_OUT; \
                if (r < I_UP) { transpose_item<2>(INF(8) + (size_t)l_ * D * NUP, D, NUP, (bf16_t*)WSP(WS_WUP) + (size_t)l_ * NUP * D, INF(7) + l_ * D, scr, r, lane_); continue; } r -= I_UP; \
                transpose_item<0, false>(INF(11) + (size_t)l_ * DFF * D, DFF, D, (bf16_t*)WSP(WS_WDOWN) + (size_t)l_ * D * DFF, nullptr, scr, r, lane_); } \
            __syncthreads(); } } while (0)
#pragma nounroll
    for (int l = 0; l < 2; ++l) {
#define OPQ() int tid_ = threadIdx.x, G_ = gridDim.x, bid_ = blockIdx.x; asm volatile("" : "+v"(tid_), "+s"(G_), "+s"(bid_)); const int lane_ = tid_ & 63, wave_ = __builtin_amdgcn_readfirstlane(tid_ >> 6), gw_ = bid_ * NWAVES + wave_, ngw_ = G_ * NWAVES, gt_ = bid_ * NTHREADS + tid_, ngt_ = G_ * NTHREADS; (void)lane_; (void)gw_; (void)ngw_; (void)gt_; (void)ngt_
        { OPQ(); pg8::Gemm g{XB, (bf16_t*)WSP(WS_WIN) + (size_t)l * NIN * D, M, NIN, D}; pg8::StaticOrder S; S.init(M, NIN, G_, bid_, l == 0);
          pg8::EpiInProj E{PROJ, SS + (size_t)(2 * l) * M * 8, (LAS float*)(lds + 147456), (LAS float*)(lds + 131072 + 15360)};
          pg8::gemm_phase<pg8::EpiInProj, pg8::StaticOrder, true, true>(lds, g, S, E);
          if (l == 0) { __syncthreads(); CONVERT_SET(0, false); } }
        GSYNC();
        { OPQ(); attn_phase(lds, PROJ, AO, AL, MIX, sink_b + l * 10, rpb_c + l * 10 * 465, gw_, ngw_, wave_, lane_); }
        GSYNC();
        { OPQ(); mixnorm_phase(AO, AL, MIX, gw_, ngw_, lane_); }
        GSYNC();
        { OPQ(); pg8::Gemm g{MIX, (bf16_t*)WSP(WS_WOUT) + (size_t)l * D * D, M, D, D}; pg8::StaticOrder S; S.init(M, D, G_, bid_);
          pg8::EpiResid E{XB, SS + (size_t)(2 * l + 1) * M * 8, (LAS float*)(lds + 131072 + 1024)};
          pg8::gemm_phase<pg8::EpiResid, pg8::StaticOrder, true, true>(lds, g, S, E); }
        GSYNC();
        { OPQ(); pg8::Gemm g{XB, (bf16_t*)WSP(WS_WUP) + (size_t)l * NUP * D, M, NUP, D}; pg8::StaticOrder S; S.init(M, NUP, G_, bid_, l == 0);
          pg8::EpiUpConv E{GB, SS + (size_t)(2 * l + 1) * M * 8, CWT + (size_t)l * 4 * NUP, EPART, ERAW, (LAS float*)(lds + 131072 + 1024), (LAS float*)(lds + 131072 + 15360), (LAS float*)(lds + 147456), (LAS float*)(lds + 131072 + 7168)};
          pg8::gemm_phase<pg8::EpiUpConv, pg8::StaticOrder, true, true>(lds, g, S, E);
          if (l == 0) { __syncthreads(); CONVERT_SET(1, true); } }
        GSYNC();
        { OPQ(); const float* ep = EPART; const float* er = ERAW; const float* cwl = CWT + (size_t)l * 4 * NUP; bf16_t* gb = GB;
          for (int i = gt_; i < 128 * (DFF / 4); i += ngt_) { const int rr = i / (DFF / 4), j4 = (i % (DFF / 4)) * 4, pm = rr >> 1, which = rr & 1, np = 256 * (j4 >> 7) + (j4 & 127);
            const bool has = which ? ((pm & 7) != 7) : ((pm & 7) != 0); const int pmn = which ? pm + 1 : pm - 1;
            f32x4 uu[2];
#pragma unroll
            for (int bj = 0; bj < 2; ++bj) { const size_t o = (size_t)(pm * 2 + which) * NUP + np + 128 * bj; f32x4 v = *(const f32x4*)(ep + o);
                if (has) { const f32x4 nb = *(const f32x4*)(er + (size_t)(pmn * 2 + (1 - which)) * NUP + np + 128 * bj), w = *(const f32x4*)(cwl + (size_t)(which ? 2 : 0) * NUP + np + 128 * bj); v = v + w * nb; }
                uu[bj] = v; }
            float gg[4];
#pragma unroll
            for (int e = 0; e < 4; ++e) { const float xg = uu[0][e]; gg[e] = xg * __builtin_amdgcn_rcpf(1.0f + __builtin_amdgcn_exp2f(-LOG2E * xg)) * uu[1][e]; }
            u32x2 w; w.x = pk_bf16(gg[0], gg[1]); w.y = pk_bf16(gg[2], gg[3]);
            *(u32x2*)(gb + (size_t)(pm * 256 + (which ? 255 : 0)) * DFF + j4) = w; } }
        GSYNC();
        { OPQ(); pg8::Gemm g{GB, (bf16_t*)WSP(WS_WDOWN) + (size_t)l * D * DFF, M, D, DFF}; pg8::StaticOrder S; S.init(M, D, G_, bid_);
          pg8::EpiResid E{XB, SS + (size_t)(2 * l + 2) * M * 8, (LAS float*)(lds + 131072 + 1024)};
          pg8::gemm_phase<pg8::EpiResid, pg8::StaticOrder, true, true>(lds, g, S, E); }
        GSYNC();
    }
    OPQ(); float* fo_ = out; const float* fss_ = SS; const float* fg_ = ln_final; const bf16_t* fx_ = XB;
    for (int m = gw_; m < M; m += ngw_) { const int lane = lane_;
        float sp = (lane < 8) ? fss_[((size_t)4 * M + m) * 8 + lane] : 0.f; sp = wave_sum(sp);
        const float rs = __builtin_amdgcn_rsqf(sp * (1.0f / 2048.0f) + EPS);
        f32x4* xr = (f32x4*)(fo_ + (size_t)m * D) + lane; const f32x4* gr = (const f32x4*)fg_ + lane; const u32x2* br = (const u32x2*)(fx_ + (size_t)m * D) + lane; u32x2 bq[8]; f32x4 gq[8];
#pragma unroll
        for (int j = 0; j < 8; ++j) { bq[j] = br[64 * j]; gq[j] = gr[64 * j]; }
#pragma unroll
        for (int j = 0; j < 8; ++j) { const u32x2 b = bq[j]; const f32x4 v = {bflo(b.x), bfhi(b.x), bflo(b.y), bfhi(b.y)}; xr[64 * j] = v * rs * gq[j]; }
    }
}
#undef out
#undef x_in
#undef SS
extern "C" void kernel_launch(void* const* d_in, const int* in_sizes, int n_in, void* d_out, int out_size, void* d_ws, size_t ws_size, hipStream_t stream) {
    static int grid = 0;
    if (grid == 0) {
        if (n_in != 13 || out_size != M * D || ws_size < WS_END) { fprintf(stderr, "kernel_launch: unexpected shapes (n_in %d out %d ws %zu)\n", n_in, out_size, ws_size); grid = -1; return; }
        int dev = 0, cus = 0, per = 0;
        (void)hipGetDevice(&dev);
        (void)hipDeviceGetAttribute(&cus, hipDeviceAttributeMultiprocessorCount, dev);
        (void)hipFuncSetAttribute((const void*)fwd_kernel, hipFuncAttributeMaxDynamicSharedMemorySize, LDS_BYTES);
        (void)hipOccupancyMaxActiveBlocksPerMultiprocessor(&per, (const void*)fwd_kernel, NTHREADS, LDS_BYTES);
        if (per < 1) per = 1;
        grid = cus * per;
    }
    if (grid < 0) return;
    Args a{};
    for (int i = 0; i < 13; ++i) a.in[i] = (const float*)d_in[i];
    a.out = (float*)d_out; a.ws = (unsigned char*)d_ws;
    void* args[] = {&a};
    hipError_t e = hipLaunchCooperativeKernel((void*)fwd_kernel, dim3(grid), dim3(NTHREADS), args, LDS_BYTES, stream);
    if (e != hipSuccess) fprintf(stderr, "cooperative launch failed: %s (grid %d)\n", hipGetErrorString(e), grid);
}
```
